# Optimizing an MI355X kernel written in HIP

```python
import math
import jax, jax.numpy as jnp
from jax import lax
import numpy as np

D_MODEL = 1024
BATCH = 4
SEQ = 8192
DEPTH = 4

CTX_LEN = 256
GRID_W = 64
N_EVEN = (DEPTH + 1) // 2
N_ODD = DEPTH // 2
EPS = 1e-6
N_MOD = 6
D_FF = 4 * D_MODEL
C_HYENA = D_MODEL // 2
HYENA_ORDER = 2
HYENA_SHORT_W = 3
N_BANDS = 16
FILTER_EMB = 1 + 2 * N_BANDS
FILTER_HIDDEN = 64
DECAY_MIN = math.log(100.0) / 1.5
DECAY_MAX = math.log(100.0) / 0.3
DIFF_HEAD_DIM = 64
DIFF_V_DIM = 2 * DIFF_HEAD_DIM
DIFF_HEADS = (D_MODEL // 2) // DIFF_V_DIM
C_DIFF = DIFF_HEADS * DIFF_V_DIM
QK_WIDTH = DIFF_HEADS * 2 * DIFF_HEAD_DIM
HY_WIDTH = 3 * C_HYENA
D_EVEN_IN = HY_WIDTH + 2 * QK_WIDTH + C_DIFF
EVEN_SPLITS = (HY_WIDTH, HY_WIDTH + QK_WIDTH, HY_WIDTH + 2 * QK_WIDTH)
KV_START = HY_WIDTH + QK_WIDTH
ROPE_AXIS = DIFF_HEAD_DIM // 2
ROPE_BASE = 10000.0
Q_BLOCK = 128
D_RNN = 1280
RG_BLOCKS = 16
RG_BS = D_RNN // RG_BLOCKS
RG_CONV_W = 4
RG_CONV_LEFT = 2
RG_C = 8.0

kernel_name = 'hybrid_hyena_diffattn_rglru_dit'


def rms_norm(x, g):
    xf = x.astype(jnp.float32)
    y = xf * lax.rsqrt(jnp.mean(xf * xf, axis=-1, keepdims=True) + EPS)
    return (y * g.astype(jnp.float32)).astype(x.dtype)


def modulate(x, g, shift, scale):
    return rms_norm(x, g) * (1.0 + scale) + shift


def ada_mod(cond, w, b, n):
    m = jax.nn.silu(cond) @ w[:, :n * D_MODEL] + b[:n * D_MODEL]
    return jnp.split(m, n, axis=-1)


def dw_conv(x, w, b, left):
    width, L = w.shape[0], x.shape[1]
    xp = jnp.pad(x, ((0, 0), (left, width - 1 - left), (0, 0)))
    return sum(w[j] * xp[:, j:j + L] for j in range(width)) + b


def sq_relu_mlp(x, w1, w2):
    return jnp.square(jax.nn.relu(x @ w1)) @ w2


def hyena_filters(L, w1, b1, w2, b2, w3, b3, freq, decay):
    t = jnp.arange(L, dtype=jnp.float32) / L
    bands = jnp.arange(1, N_BANDS + 1, dtype=jnp.float32)
    ang = 2.0 * math.pi * t[:, None] * bands
    feats = jnp.concatenate([t[:, None], jnp.cos(ang), jnp.sin(ang)], axis=-1)
    h = jnp.sin(freq * (feats @ w1 + b1))
    h = jnp.sin(freq * (h @ w2 + b2))
    h = (h @ w3 + b3).reshape(L, HYENA_ORDER, 2, C_HYENA)
    h = h * jnp.exp(-t[:, None, None, None] * jnp.abs(decay))
    hf, hb = h[:, :, 0], h[:, :, 1]
    return jnp.concatenate([hf, jnp.zeros_like(hf[:1]), hb[:0:-1]], axis=0)


def fft_long_conv(u, k_hat, bias):
    L = u.shape[1]
    U = jnp.fft.rfft(u.astype(jnp.float32), n=2 * L, axis=1)
    y = jnp.fft.irfft(U * k_hat, n=2 * L, axis=1)[:, :L]
    return (y + u * bias).astype(u.dtype)


def hyena_mix(u3, short_w, short_b, hy_bias, fparams):
    L = u3.shape[1]
    u3 = dw_conv(u3, short_w, short_b, 1)
    v, x1, x2 = jnp.split(u3, 3, axis=-1)
    k_hat = jnp.fft.rfft(hyena_filters(L, *fparams), axis=0)
    z = x1 * fft_long_conv(v, k_hat[:, 0], hy_bias[0])
    z = x2 * fft_long_conv(z, k_hat[:, 1], hy_bias[1])
    return z


def axial_rope(x, rows, cols):
    freqs = ROPE_BASE ** (-jnp.arange(0, ROPE_AXIS, 2, dtype=jnp.float32) / ROPE_AXIS)

    def rot(xa, pos):
        ang = pos[:, None] * freqs
        cos = jnp.cos(ang)[:, None, None, :]
        sin = jnp.sin(ang)[:, None, None, :]
        a1, a2 = jnp.split(xa, 2, axis=-1)
        return jnp.concatenate([a1 * cos - a2 * sin, a2 * cos + a1 * sin], axis=-1)

    out = jnp.concatenate([rot(x[..., :ROPE_AXIS], rows), rot(x[..., ROPE_AXIS:], cols)], axis=-1)
    return out.astype(x.dtype)


def diff_attend(q, k, v, lam):
    s = jnp.einsum('bqhjd,bkhjd->bhjqk', q, k).astype(jnp.float32) * (DIFF_HEAD_DIM ** -0.5)
    p = jax.nn.softmax(s, axis=-1)
    a = p[:, :, 0] - lam * p[:, :, 1]
    return jnp.einsum('bhqk,bkhe->bqhe', a.astype(v.dtype), v)


def diff_heads_out(o, subln_g, lam_init):
    B, L = o.shape[:2]
    return (rms_norm(o, subln_g) * (1.0 - lam_init)).reshape(B, L, C_DIFF)


def even_mixer(h_ctx, h_lat, rows, cols, w_in, w_out, short_w, short_b,
               f_w1, f_b1, f_w2, f_b2, f_w3, f_b3, f_freq, f_decay, hy_bias,
               lq1, lk1, lq2, lk2, subln_g, lam_init, ctx_out):
    B, L, _ = h_lat.shape
    Lc = h_ctx.shape[1]
    fparams = (f_w1, f_b1, f_w2, f_b2, f_w3, f_b3, f_freq, f_decay)
    lam = jnp.exp(jnp.sum(lq1 * lk1)) - jnp.exp(jnp.sum(lq2 * lk2)) + lam_init
    qk_shape = (DIFF_HEADS, 2, DIFF_HEAD_DIM)
    u_lat, q_lat, k_lat, v_lat = jnp.split(h_lat @ w_in, EVEN_SPLITS, axis=-1)
    q_lat = axial_rope(q_lat.reshape(B, L, *qk_shape), rows, cols)
    k_lat = axial_rope(k_lat.reshape(B, L, *qk_shape), rows, cols)
    v_lat = v_lat.reshape(B, L, DIFF_HEADS, DIFF_V_DIM)
    if ctx_out:
        u_ctx, q_ctx, k_ctx, v_ctx = jnp.split(h_ctx @ w_in, EVEN_SPLITS, axis=-1)
        q_ctx = q_ctx.reshape(B, Lc, *qk_shape)
    else:
        k_ctx, v_ctx = jnp.split(h_ctx @ w_in[:, KV_START:], 2, axis=-1)
    k_ctx = k_ctx.reshape(B, Lc, *qk_shape)
    v_ctx = v_ctx.reshape(B, Lc, DIFF_HEADS, DIFF_V_DIM)
    k_all = jnp.concatenate([k_lat, k_ctx], axis=1)
    v_all = jnp.concatenate([v_lat, v_ctx], axis=1)
    n_blk = L // Q_BLOCK
    q_blocks = jnp.moveaxis(q_lat.reshape(B, n_blk, Q_BLOCK, *qk_shape), 1, 0)
    o_lat = lax.map(lambda qb: diff_attend(qb, k_all, v_all, lam), q_blocks)
    o_lat = jnp.moveaxis(o_lat, 0, 1).reshape(B, L, DIFF_HEADS, DIFF_V_DIM)
    y_lat = jnp.concatenate([hyena_mix(u_lat, short_w, short_b, hy_bias, fparams),
                             diff_heads_out(o_lat, subln_g, lam_init)], axis=-1) @ w_out
    if not ctx_out:
        return None, y_lat
    o_ctx = diff_attend(q_ctx, k_ctx, v_ctx, lam)
    y_ctx = jnp.concatenate([hyena_mix(u_ctx, short_w, short_b, hy_bias, fparams),
                             diff_heads_out(o_ctx, subln_g, lam_init)], axis=-1) @ w_out
    return y_ctx, y_lat


def rglru_gates(xc, wa, ba, wx, bx, lam):
    B, L, _ = xc.shape
    xb = xc.reshape(B, L, RG_BLOCKS, RG_BS)
    r = jax.nn.sigmoid(jnp.einsum('blnc,ncd->blnd', xb, wa).reshape(B, L, D_RNN) + ba)
    i = jax.nn.sigmoid(jnp.einsum('blnc,ncd->blnd', xb, wx).reshape(B, L, D_RNN) + bx)
    log_a = -RG_C * r.astype(jnp.float32) * jax.nn.softplus(-lam.astype(jnp.float32))
    a = jnp.exp(log_a)
    b = jnp.sqrt(-jnp.expm1(2.0 * log_a)) * (i * xc).astype(jnp.float32)
    return a, b


def _combine(left, right):
    return (left[0] * right[0], right[0] * left[1] + right[1])


def linear_scan(a, b, h0):
    A, Bc = lax.associative_scan(_combine, (a, b), axis=1)
    return Bc if h0 is None else Bc + A * h0[:, None, :]


def odd_mixer(h_ctx, h_lat, w_in, w_out, conv_w, conv_b, wa, ba, wx, bx, lam, ctx_out):
    g_lat, x_lat = jnp.split(h_lat @ w_in, 2, axis=-1)
    if ctx_out:
        g_ctx, x_ctx = jnp.split(h_ctx @ w_in, 2, axis=-1)
    else:
        x_ctx = h_ctx @ w_in[:, D_RNN:]
    x_ctx = dw_conv(x_ctx, conv_w, conv_b, RG_CONV_LEFT)
    x_lat = dw_conv(x_lat, conv_w, conv_b, RG_CONV_LEFT)
    h_lat_dirs, h_ctx_dirs = [], []
    for d in range(2):
        flip = (lambda t: jnp.flip(t, axis=1)) if d == 1 else (lambda t: t)
        a_c, b_c = rglru_gates(flip(x_ctx), wa[d], ba[d], wx[d], bx[d], lam[d])
        h_c = linear_scan(a_c, b_c, None)
        a_l, b_l = rglru_gates(flip(x_lat), wa[d], ba[d], wx[d], bx[d], lam[d])
        h_lat_dirs.append(flip(linear_scan(a_l, b_l, h_c[:, -1])))
        if ctx_out:
            h_ctx_dirs.append(flip(h_c))
    y_lat = ((h_lat_dirs[0] + h_lat_dirs[1]).astype(g_lat.dtype) * jax.nn.gelu(g_lat)) @ w_out
    if not ctx_out:
        return None, y_lat
    y_ctx = ((h_ctx_dirs[0] + h_ctx_dirs[1]).astype(g_ctx.dtype) * jax.nn.gelu(g_ctx)) @ w_out
    return y_ctx, y_lat


def setup_inputs(seed: int = 0) -> dict:
    key = jax.random.key(seed)
    ks = iter(jax.random.split(key, 48))

    def nrm(shape, scale):
        return scale * jax.random.normal(next(ks), shape, jnp.float32)

    D = D_MODEL
    decay0 = jnp.linspace(DECAY_MIN, DECAY_MAX, C_HYENA, dtype=jnp.float32)
    a0 = jax.random.uniform(next(ks), (N_ODD, 2, D_RNN), jnp.float32, 0.9, 0.999)
    s0 = a0 ** (1.0 / RG_C)
    rg_lam = jnp.log(s0) - jnp.log1p(-s0)
    return {
        'x': nrm((BATCH, SEQ, D), 1.0),
        'c': nrm((BATCH, D), 1.0),
        'ctx': nrm((BATCH, CTX_LEN, D), 1.0),
        'c_ctx': nrm((D,), 1.0),
        'ada_w': nrm((DEPTH, D, N_MOD * D), 0.5 * D ** -0.5),
        'ada_b': nrm((DEPTH, N_MOD * D), 0.02),
        'norm1_g': 1.0 + nrm((DEPTH, D), 0.02),
        'norm2_g': 1.0 + nrm((DEPTH, D), 0.02),
        'mlp_w1': nrm((DEPTH, D, D_FF), D ** -0.5),
        'mlp_w2': nrm((DEPTH, D_FF, D), D_FF ** -0.5),
        'final_g': 1.0 + nrm((D,), 0.02),
        'ev_w_in': nrm((N_EVEN, D, D_EVEN_IN), D ** -0.5),
        'ev_w_out': nrm((N_EVEN, C_HYENA + C_DIFF, D), (C_HYENA + C_DIFF) ** -0.5),
        'hy_short_w': nrm((N_EVEN, HYENA_SHORT_W, HY_WIDTH), HYENA_SHORT_W ** -0.5),
        'hy_short_b': nrm((N_EVEN, HY_WIDTH), 0.02),
        'hy_f_w1': nrm((N_EVEN, FILTER_EMB, FILTER_HIDDEN), FILTER_EMB ** -0.5),
        'hy_f_b1': nrm((N_EVEN, FILTER_HIDDEN), 0.02),
        'hy_f_w2': nrm((N_EVEN, FILTER_HIDDEN, FILTER_HIDDEN), FILTER_HIDDEN ** -0.5),
        'hy_f_b2': nrm((N_EVEN, FILTER_HIDDEN), 0.02),
        'hy_f_w3': nrm((N_EVEN, FILTER_HIDDEN, HYENA_ORDER * 2 * C_HYENA), 0.05 * FILTER_HIDDEN ** -0.5),
        'hy_f_b3': nrm((N_EVEN, HYENA_ORDER * 2 * C_HYENA), 0.005),
        'hy_f_freq': 1.0 + nrm((N_EVEN, FILTER_HIDDEN), 0.1),
        'hy_f_decay': decay0 + nrm((N_EVEN, HYENA_ORDER, 2, C_HYENA), 0.1),
        'hy_bias': nrm((N_EVEN, HYENA_ORDER, C_HYENA), 1.0),
        'df_lq1': nrm((N_EVEN, DIFF_HEAD_DIM), 0.1),
        'df_lk1': nrm((N_EVEN, DIFF_HEAD_DIM), 0.1),
        'df_lq2': nrm((N_EVEN, DIFF_HEAD_DIM), 0.1),
        'df_lk2': nrm((N_EVEN, DIFF_HEAD_DIM), 0.1),
        'df_subln_g': 1.0 + nrm((N_EVEN, DIFF_V_DIM), 0.02),
        'od_w_in': nrm((N_ODD, D, 2 * D_RNN), D ** -0.5),
        'od_w_out': nrm((N_ODD, D_RNN, D), D_RNN ** -0.5),
        'rg_conv_w': nrm((N_ODD, RG_CONV_W, D_RNN), RG_CONV_W ** -0.5),
        'rg_conv_b': nrm((N_ODD, D_RNN), 0.02),
        'rg_wa': nrm((N_ODD, 2, RG_BLOCKS, RG_BS, RG_BS), RG_BS ** -0.5),
        'rg_ba': nrm((N_ODD, 2, D_RNN), 0.02),
        'rg_wx': nrm((N_ODD, 2, RG_BLOCKS, RG_BS, RG_BS), RG_BS ** -0.5),
        'rg_bx': nrm((N_ODD, 2, D_RNN), 0.02),
        'rg_lam': rg_lam,
    }


def reference(x, c, ctx, c_ctx, ada_w, ada_b, norm1_g, norm2_g, mlp_w1, mlp_w2, final_g,
              ev_w_in, ev_w_out, hy_short_w, hy_short_b, hy_f_w1, hy_f_b1, hy_f_w2, hy_f_b2,
              hy_f_w3, hy_f_b3, hy_f_freq, hy_f_decay, hy_bias, df_lq1, df_lk1, df_lq2, df_lk2,
              df_subln_g, od_w_in, od_w_out, rg_conv_w, rg_conv_b, rg_wa, rg_ba, rg_wx, rg_bx, rg_lam):
    B, L, _ = x.shape
    ROWS = L // GRID_W
    rows = jnp.repeat(jnp.arange(ROWS, dtype=jnp.float32), GRID_W)
    cols = jnp.tile(jnp.arange(GRID_W, dtype=jnp.float32), ROWS)
    c_lat = c[:, None, :]
    h_lat, h_ctx = x, ctx
    for i in range(DEPTH):
        last = i == DEPTH - 1
        j = i // 2
        sh1, sc1, g1, sh2, sc2, g2 = ada_mod(c_lat, ada_w[i], ada_b[i], N_MOD)
        if last:
            csh1, csc1 = ada_mod(c_ctx, ada_w[i], ada_b[i], 2)
        else:
            csh1, csc1, cg1, csh2, csc2, cg2 = ada_mod(c_ctx, ada_w[i], ada_b[i], N_MOD)
        n_lat = modulate(h_lat, norm1_g[i], sh1, sc1)
        n_ctx = modulate(h_ctx, norm1_g[i], csh1, csc1)
        if i % 2 == 0:
            y_ctx, y_lat = even_mixer(
                n_ctx, n_lat, rows, cols, ev_w_in[j], ev_w_out[j], hy_short_w[j], hy_short_b[j],
                hy_f_w1[j], hy_f_b1[j], hy_f_w2[j], hy_f_b2[j], hy_f_w3[j], hy_f_b3[j], hy_f_freq[j],
                hy_f_decay[j], hy_bias[j], df_lq1[j], df_lk1[j], df_lq2[j], df_lk2[j], df_subln_g[j],
                0.8 - 0.6 * math.exp(-0.3 * i), not last)
        else:
            y_ctx, y_lat = odd_mixer(
                n_ctx, n_lat, od_w_in[j], od_w_out[j], rg_conv_w[j], rg_conv_b[j],
                rg_wa[j], rg_ba[j], rg_wx[j], rg_bx[j], rg_lam[j], not last)
        h_lat = h_lat + g1 * y_lat
        h_lat = h_lat + g2 * sq_relu_mlp(modulate(h_lat, norm2_g[i], sh2, sc2), mlp_w1[i], mlp_w2[i])
        if not last:
            h_ctx = h_ctx + cg1 * y_ctx
            h_ctx = h_ctx + cg2 * sq_relu_mlp(modulate(h_ctx, norm2_g[i], csh2, csc2), mlp_w1[i], mlp_w2[i])
    return rms_norm(h_lat, final_g)
```

```cpp
#include <hip/hip_runtime.h>
#include <hip/hip_cooperative_groups.h>
#include <cstdio>
#include <cstdint>
namespace cg = cooperative_groups;
namespace pg8 {
#define PG8_LAS __attribute__((address_space(3)))
typedef unsigned short bf16_t;
typedef short bf16x8 __attribute__((ext_vector_type(8)));
typedef float f32x4 __attribute__((ext_vector_type(4)));
typedef unsigned u32x4 __attribute__((ext_vector_type(4)));
constexpr int BM = 256, BK = 64, HALF = 128, HTB = HALF * BK * 2  , STAGE_BYTES = 8 * HTB, NXCD = 8, WGM = 8;

__host__ __device__ __forceinline__ int lds_byte(int r, int c) { const int st = (r >> 4) * 2 + (c >> 5), rr = r & 15, cc = c & 31, ob = rr * 64 + cc * 2; return st * 1024 + (ob ^ (((ob >> 9) & 1) << 5)); }
__host__ __device__ __forceinline__ void stage_rc(int b, int& R, int& C) { const int st = b / 1024, sb = b % 1024, swz = sb ^ (((sb >> 9) & 1) << 5); R = (st >> 1) * 16 + swz / 64; C = (st & 1) * 32 + (swz % 64) / 2; }
__host__ __device__ __forceinline__ int perm32(int rho) { const int n = rho >> 4, i = rho & 15; return 8 * (i >> 2) + 4 * n + (i & 3); }

struct Unit { int pm, pn; };
struct Gemm { const bf16_t* A; const bf16_t* Bt; int M, N, K; };

struct StaticOrder {
    int nM, nN, nwg, G, c;
    __host__ __device__ void init(int M, int N, int G_, int c_) { nM = M / BM; nN = N / BM; nwg = nM * nN; G = G_; c = c_; }
    __host__ __device__ bool next(int i, Unit& u) const {
        const long L = (long)i * G + c; if (L >= nwg) return false;
        int wgid = (int)L; { const int q = nwg / NXCD, r = nwg % NXCD, xcd = wgid % NXCD, off = wgid / NXCD; wgid = (xcd < r ? xcd * (q + 1) : r * (q + 1) + (xcd - r) * q) + off; }
        const int nig = WGM * nN, gid = wgid / nig, fm = gid * WGM, gsz = (nM - fm) < WGM ? (nM - fm) : WGM;
        u.pm = fm + ((wgid % nig) % gsz); u.pn = (wgid % nig) / gsz; return true;
    }
    __device__ __forceinline__ void a_ready(const Unit&) const {}
    __device__ __forceinline__ void done(const Unit&) const {}
};

__device__ __forceinline__ unsigned cvt_pk_bf16(float lo, float hi) { unsigned r; asm volatile("v_cvt_pk_bf16_f32 %0, %1, %2" : "=v"(r) : "v"(lo), "v"(hi)); return r; }
template <class Epi, class Sched, bool ALIGN_EPI = false, bool SP2 = false>
__device__ __forceinline__ void gemm_phase(PG8_LAS unsigned char* lds, const Gemm g, const Sched& S, const Epi& E) {
    int tid_op = threadIdx.x; asm volatile("" : "+v"(tid_op));
    const int tid = tid_op, wid = __builtin_amdgcn_readfirstlane(tid >> 6), lane = tid & 63, wr = wid >> 2, wc = wid & 3, fr = lane & 15, fq = lane >> 4;
    const int K = g.K, nt = K / BK;
    unsigned voffA[2], voffB[2];
#pragma unroll
    for (int i = 0; i < 2; ++i) { int R, C; stage_rc(tid * 16 + i * 8192, R, C); const int Rb = Epi::PERM ? ((R & ~31) + perm32(R & 31)) : R;
        voffA[i] = (unsigned)(R * K + C) * 2u; voffB[i] = (unsigned)(Rb * K + C) * 2u; }
    const size_t kstep = (size_t)(BK * 2);
    const size_t hstep = (size_t)HALF * K * 2;
    const size_t tstep = 2 * hstep;
    const unsigned ldsw = (unsigned)wid * 1024u;
    const int aoff = lds_byte(wr * 64 + fr, fq * 8), boff = lds_byte(wc * 32 + fr, fq * 8);
#define PG8_SA(b, h) (((b) * 2 + (h)) * HTB)
#define PG8_SB(b, h) ((4 + (b) * 2 + (h)) * HTB)
#define PG8_STAGE(bufoff, gbase, voff) do { _Pragma("unroll") for (int _i = 0; _i < 2; ++_i) \
        __builtin_amdgcn_global_load_lds((const unsigned*)((const char*)(gbase) + (voff)[_i]), (PG8_LAS unsigned*)(lds + (bufoff) + ldsw + _i * 8192), 16, 0, 0); } while (0)
#define PG8_LDA(dst, b, h) do { _Pragma("unroll") for (int m = 0; m < 4; ++m) _Pragma("unroll") for (int k = 0; k < 2; ++k) dst[m][k] = *(const PG8_LAS bf16x8*)(lds + PG8_SA(b, h) + aoff + m * 2048 + k * 1024); } while (0)
#define PG8_LDB(dst, b, h) do { _Pragma("unroll") for (int n = 0; n < 2; ++n) _Pragma("unroll") for (int k = 0; k < 2; ++k) dst[n][k] = *(const PG8_LAS bf16x8*)(lds + PG8_SB(b, h) + boff + n * 2048 + k * 1024); } while (0)
#define PG8_MMA(ai, bj, At, Bt) do { __builtin_amdgcn_s_setprio(1); _Pragma("unroll") for (int m = 0; m < 4; ++m) _Pragma("unroll") for (int n = 0; n < 2; ++n) _Pragma("unroll") for (int k = 0; k < 2; ++k) \
        acc[ai][bj][m][n] = __builtin_amdgcn_mfma_f32_16x16x32_bf16(Bt[n][k], At[m][k], acc[ai][bj][m][n], 0, 0, 0); __builtin_amdgcn_s_setprio(0); } while (0)
#define PG8_WAIT_V(n) asm volatile("s_waitcnt vmcnt(" #n ")" ::: "memory")
#define PG8_WAIT_L(n) asm volatile("s_waitcnt lgkmcnt(" #n ")" ::: "memory")
#define PG8_BAR __builtin_amdgcn_s_barrier()
#define PG8_SCHED __builtin_amdgcn_sched_barrier(0)
    Unit cur, nxt; int ui = 0;
    if (!S.next(0, cur)) return;
    f32x4 acc[2][2][4][2];
#pragma unroll
    for (int a = 0; a < 2; ++a)
#pragma unroll
        for (int b = 0; b < 2; ++b)
#pragma unroll
            for (int m = 0; m < 4; ++m)
#pragma unroll
                for (int n = 0; n < 2; ++n) acc[a][b][m][n] = (f32x4){0.f, 0.f, 0.f, 0.f};
    bf16x8 At[4][2], B0[2][2], B1[2][2];
    const char* cA = (const char*)g.A + (size_t)cur.pm * tstep; const char* cB = (const char*)g.Bt + (size_t)cur.pn * tstep;
    S.a_ready(cur);
    if constexpr (SP2) {
        PG8_STAGE(PG8_SB(0, 0), cB, voffB); PG8_STAGE(PG8_SB(0, 1), cB + hstep, voffB); PG8_STAGE(PG8_SA(0, 0), cA, voffA); PG8_STAGE(PG8_SA(0, 1), cA + hstep, voffA);
        if (wr == 1) PG8_BAR;
        PG8_WAIT_V(2); PG8_BAR;
        PG8_STAGE(PG8_SB(1, 0), cB + kstep, voffB); PG8_STAGE(PG8_SA(1, 0), cA + kstep, voffA); PG8_STAGE(PG8_SB(1, 1), cB + hstep + kstep, voffB);
        PG8_WAIT_V(6); PG8_BAR;
    } else {
        PG8_STAGE(PG8_SB(0, 0), cB, voffB); PG8_STAGE(PG8_SA(0, 0), cA, voffA); PG8_STAGE(PG8_SB(0, 1), cB + hstep, voffB); PG8_STAGE(PG8_SA(0, 1), cA + hstep, voffA);
        if (wr == 1) PG8_BAR;
        PG8_WAIT_V(4); PG8_BAR;
        PG8_STAGE(PG8_SB(1, 0), cB + kstep, voffB); PG8_STAGE(PG8_SA(1, 0), cA + kstep, voffA); PG8_STAGE(PG8_SB(1, 1), cB + hstep + kstep, voffB);
        PG8_WAIT_V(6); PG8_BAR;
    }
    for (;;) {
        const bool has_next = S.next(ui + 1, nxt);
        const char* nA = has_next ? (const char*)g.A + (size_t)nxt.pm * tstep : cA; const char* nB = has_next ? (const char*)g.Bt + (size_t)nxt.pn * tstep : cB;
        for (int t = 0; t < nt; t += 2) {
            const bool last = (t == nt - 2);
            const char* a1 = cA + (size_t)(t + 1) * kstep;
            const char* a2 = last ? nA : cA + (size_t)(t + 2) * kstep; const char* b2 = last ? nB : cB + (size_t)(t + 2) * kstep;
            const char* a3 = a2 + kstep; const char* b3 = b2 + kstep;
            if (last && has_next) S.a_ready(nxt);
            if constexpr (SP2) {
            PG8_LDB(B0, 0, 0); PG8_LDB(B1, 0, 1); PG8_SCHED; PG8_LDA(At, 0, 0); PG8_STAGE(PG8_SA(1, 1), a1 + hstep, voffA);
            PG8_WAIT_V(8); PG8_WAIT_L(0); PG8_BAR; PG8_MMA(0, 0, At, B0); PG8_MMA(0, 1, At, B1); PG8_BAR; PG8_SCHED;
            PG8_LDA(At, 0, 1); PG8_STAGE(PG8_SB(0, 0), b2, voffB); PG8_STAGE(PG8_SB(0, 1), b2 + hstep, voffB); PG8_STAGE(PG8_SA(0, 0), a2, voffA);
            PG8_WAIT_V(8); PG8_WAIT_L(0); PG8_BAR; PG8_MMA(1, 0, At, B0); PG8_MMA(1, 1, At, B1); PG8_BAR; PG8_SCHED;
            PG8_LDB(B0, 1, 0); PG8_LDB(B1, 1, 1); PG8_SCHED; PG8_LDA(At, 1, 0); PG8_STAGE(PG8_SA(0, 1), a2 + hstep, voffA);
            PG8_WAIT_V(8); PG8_WAIT_L(0); PG8_BAR; PG8_MMA(0, 0, At, B0); PG8_MMA(0, 1, At, B1); PG8_BAR; PG8_SCHED;
            PG8_LDA(At, 1, 1); PG8_STAGE(PG8_SB(1, 0), b3, voffB); PG8_STAGE(PG8_SB(1, 1), b3 + hstep, voffB); PG8_STAGE(PG8_SA(1, 0), a3, voffA);
            PG8_WAIT_V(8); PG8_WAIT_L(0); PG8_BAR; PG8_MMA(1, 0, At, B0); PG8_MMA(1, 1, At, B1); PG8_BAR; PG8_SCHED;
            } else {
            PG8_LDB(B0, 0, 0); PG8_SCHED; PG8_LDA(At, 0, 0); PG8_STAGE(PG8_SA(1, 1), a1 + hstep, voffA);
            PG8_WAIT_L(8); PG8_BAR; PG8_WAIT_L(0); PG8_MMA(0, 0, At, B0); PG8_BAR; PG8_SCHED;
            PG8_LDB(B1, 0, 1); PG8_STAGE(PG8_SB(0, 0), b2, voffB);
            PG8_BAR; PG8_WAIT_L(0); PG8_MMA(0, 1, At, B1); PG8_BAR;
            PG8_LDA(At, 0, 1); PG8_STAGE(PG8_SA(0, 0), a2, voffA);
            PG8_BAR; PG8_WAIT_L(0); PG8_MMA(1, 0, At, B0); PG8_BAR; PG8_SCHED;
            PG8_STAGE(PG8_SB(0, 1), b2 + hstep, voffB);
            PG8_WAIT_V(6); PG8_BAR; PG8_MMA(1, 1, At, B1); PG8_BAR;
            PG8_LDB(B0, 1, 0); PG8_SCHED; PG8_LDA(At, 1, 0); PG8_STAGE(PG8_SA(0, 1), a2 + hstep, voffA);
            PG8_WAIT_L(8); PG8_BAR; PG8_WAIT_L(0); PG8_MMA(0, 0, At, B0); PG8_BAR; PG8_SCHED;
            PG8_LDB(B1, 1, 1); PG8_STAGE(PG8_SB(1, 0), b3, voffB);
            PG8_BAR; PG8_WAIT_L(0); PG8_MMA(0, 1, At, B1); PG8_BAR;
            PG8_LDA(At, 1, 1); PG8_STAGE(PG8_SA(1, 0), a3, voffA);
            PG8_BAR; PG8_WAIT_L(0); PG8_MMA(1, 0, At, B0); PG8_BAR; PG8_SCHED;
            PG8_STAGE(PG8_SB(1, 1), b3 + hstep, voffB);
            PG8_WAIT_V(6); PG8_BAR; PG8_MMA(1, 1, At, B1); PG8_BAR;
            }
        }
        if constexpr (ALIGN_EPI) { if (wr == 0) PG8_BAR; }
        if constexpr (!Epi::AFTER_DRAIN) { E(acc, cur, wr, wc, fr, fq); S.done(cur); }
        if (!has_next) break;
#pragma unroll
        for (int a = 0; a < 2; ++a)
#pragma unroll
            for (int b = 0; b < 2; ++b)
#pragma unroll
                for (int m = 0; m < 4; ++m)
#pragma unroll
                    for (int n = 0; n < 2; ++n) acc[a][b][m][n] = (f32x4){0.f, 0.f, 0.f, 0.f};
        cur = nxt; cA = nA; cB = nB; ++ui;
        if constexpr (ALIGN_EPI) { if (wr == 1) PG8_BAR; }
    }
    PG8_WAIT_V(0);
    if constexpr (!ALIGN_EPI) { if (wr == 0) PG8_BAR; }
    PG8_BAR;
    if constexpr (Epi::AFTER_DRAIN) { E.fused(acc, cur, wr, wc, fr, fq, lds, wid, lane); S.done(cur); }
#undef PG8_SA
#undef PG8_SB
#undef PG8_STAGE
#undef PG8_LDA
#undef PG8_LDB
#undef PG8_MMA
#undef PG8_WAIT_V
#undef PG8_WAIT_L
#undef PG8_BAR
#undef PG8_SCHED
}
}

#define LAS __attribute__((address_space(3)))
typedef unsigned short bf16_t;
typedef short bf16x8 __attribute__((ext_vector_type(8)));
typedef float f32x4 __attribute__((ext_vector_type(4)));
typedef float f32x16 __attribute__((ext_vector_type(16)));
typedef unsigned u32x4 __attribute__((ext_vector_type(4)));
typedef unsigned u32x2 __attribute__((ext_vector_type(2)));
typedef _Float16 h16x2 __attribute__((ext_vector_type(2)));
typedef float cf2 __attribute__((ext_vector_type(2)));
__device__ __forceinline__ cf2 MKCF(float x, float y) { cf2 r; r.x = x; r.y = y; return r; }

constexpr int NB = 4, SEQ = 8192, DM = 1024, LC = 256;
constexpr int ML = NB * SEQ, MC = NB * LC, MT = ML + MC;
constexpr int NKEY = SEQ + LC;
constexpr int NTHR = 512;
constexpr int LDS_BYTES = 147456, LDS_BARST = 147200;
constexpr size_t MiB = 1u << 20;
constexpr size_t WS_BIG = 0, WS_ACT = 264 * MiB, WS_HCTX = 347 * MiB, WS_WB = 351 * MiB, WS_MODS = 446 * MiB, WS_H2 = 447 * MiB, WS_WSC = 452 * MiB, WS_BAR = 455 * MiB, WS_END = 456 * MiB;
constexpr size_t BIG_U = 0, BIG_Q = 99 * MiB, BIG_K = 132 * MiB, BIG_VT = 165 * MiB, BIG_KH = 198 * MiB;
constexpr size_t WB_W1 = 0, WB_W2 = WB_W1 + 4ull * 4096 * 1024, WB_EVIN = WB_W2 + 4ull * 4096 * 1024, WB_EVOUT = WB_EVIN + 2ull * 3072 * 1024,
                 WB_ODIN = WB_EVOUT + 2ull * 1024 * 1024, WB_ODOUT = WB_ODIN + 2ull * 2560 * 1024, WB_ENDE = WB_ODOUT + 2ull * 1024 * 1280;
static_assert(WB_ENDE * 2 <= 95 * MiB, "weights");
constexpr int NCH = 132;

__device__ __forceinline__ unsigned f2bf(float f) { unsigned u = __builtin_bit_cast(unsigned, f); return (u + 0x7fffu + ((u >> 16) & 1u)) >> 16; }
__device__ __forceinline__ unsigned pk2(float lo, float hi) { unsigned r; asm("v_cvt_pk_bf16_f32 %0, %1, %2" : "=v"(r) : "v"(lo), "v"(hi)); return r; }
__device__ __forceinline__ float bf2f(bf16_t h) { return __builtin_bit_cast(float, (unsigned)h << 16); }
__device__ __forceinline__ float shflx(float v, int m, int lane) { return __builtin_bit_cast(float, __builtin_amdgcn_ds_bpermute((lane ^ m) << 2, __builtin_bit_cast(int, v))); }
__device__ __forceinline__ float wave_sum(float v, int lane) {
#pragma unroll
    for (int o = 1; o < 64; o <<= 1) v += shflx(v, o, lane);
    return v;
}
__device__ __forceinline__ float sin_rev(float r) { return __builtin_amdgcn_sinf(r); }
__device__ __forceinline__ float cos_rev(float r) { return __builtin_amdgcn_cosf(r); }
__device__ __forceinline__ float fsin(float x) { float r = x * 0.15915494309189535f; r = r - floorf(r); return __builtin_amdgcn_sinf(r); }
__device__ __forceinline__ float fcos(float x) { float r = x * 0.15915494309189535f; r = r - floorf(r); return __builtin_amdgcn_cosf(r); }
__device__ __forceinline__ float sigmoidf_(float x) { return 1.0f / (1.0f + __expf(-x)); }
__device__ __forceinline__ float gelu_tanh(float g) { const float u = 0.7978845608028654f * (g + 0.044715f * g * g * g); const float t = 1.0f - 2.0f / (1.0f + __expf(2.0f * u)); return 0.5f * g * (1.0f + t); }

struct EpiStore {
    static constexpr bool PERM = true, AFTER_DRAIN = false;
    bf16_t* O; int ldc; int act;
    __device__ __forceinline__ void operator()(const f32x4 (&acc)[2][2][4][2], const pg8::Unit& u, int wr, int wc, int fr_, int fq_) const {
        int fr = fr_, fq = fq_; asm volatile("" : "+v"(fr), "+v"(fq));
        const int row0 = u.pm * 256 + wr * 64 + fr, col0 = u.pn * 256 + wc * 32 + 8 * fq;
#pragma unroll
        for (int ai = 0; ai < 2; ++ai)
#pragma unroll
            for (int m = 0; m < 4; ++m) {
                bf16_t* rowp = O + (size_t)(row0 + ai * 128 + m * 16) * ldc + col0;
#pragma unroll
                for (int bj = 0; bj < 2; ++bj) {
                    f32x4 v0 = acc[ai][bj][m][0], v1 = acc[ai][bj][m][1];
                    if (act) {
#pragma unroll
                        for (int x = 0; x < 4; ++x) { float a = fmaxf(v0[x], 0.f), b = fmaxf(v1[x], 0.f); v0[x] = a * a; v1[x] = b * b; }
                    }
                    u32x4 w; w.x = pk2(v0[0], v0[1]); w.y = pk2(v0[2], v0[3]); w.z = pk2(v1[0], v1[1]); w.w = pk2(v1[2], v1[3]);
                    *(u32x4*)(rowp + bj * 128) = w;
                }
            }
    }
};

struct EpiResid {
    static constexpr bool PERM = true, AFTER_DRAIN = false;
    const float* srcLat; const float* srcCtx; const bf16_t* SLat; const bf16_t* SCtx; bf16_t* HLat; bf16_t* HCtx; const float* mods; int gateOff;
    __device__ __forceinline__ void operator()(const f32x4 (&acc)[2][2][4][2], const pg8::Unit& u, int wr, int wc, int fr_, int fq_) const {
        int fr = fr_, fq = fq_; asm volatile("" : "+v"(fr), "+v"(fq));
        const int row0 = u.pm * 256 + wr * 64 + fr, col0 = u.pn * 256 + wc * 32 + 8 * fq;
        const int rowt = u.pm * 256;
        const float* gp = mods + (rowt < ML ? (rowt >> 13) : 4) * 6144 + gateOff + col0;
        f32x4 g[2][2];
#pragma unroll
        for (int bj = 0; bj < 2; ++bj) { g[bj][0] = *(const f32x4*)(gp + bj * 128); g[bj][1] = *(const f32x4*)(gp + bj * 128 + 4); }
        const bool f32src = srcLat != nullptr;
#pragma unroll
        for (int ai = 0; ai < 2; ++ai)
#pragma unroll
            for (int m = 0; m < 4; ++m) {
                const int row = row0 + ai * 128 + m * 16;
                const size_t off = (row < ML) ? (size_t)row * 1024 + col0 : (size_t)(row - ML) * 1024 + col0;
                bf16_t* dp = ((row < ML) ? HLat : HCtx) + off;
#pragma unroll
                for (int bj = 0; bj < 2; ++bj) {
                    f32x4 s0, s1;
                    if (f32src) { const float* sp = ((row < ML) ? srcLat : srcCtx) + off + bj * 128; s0 = *(const f32x4*)sp; s1 = *(const f32x4*)(sp + 4); }
                    else { const u32x4 w = *(const u32x4*)(((row < ML) ? SLat : SCtx) + off + bj * 128);
                        s0.x = __builtin_bit_cast(float, w.x << 16); s0.y = __builtin_bit_cast(float, w.x & 0xffff0000u); s0.z = __builtin_bit_cast(float, w.y << 16); s0.w = __builtin_bit_cast(float, w.y & 0xffff0000u);
                        s1.x = __builtin_bit_cast(float, w.z << 16); s1.y = __builtin_bit_cast(float, w.z & 0xffff0000u); s1.z = __builtin_bit_cast(float, w.w << 16); s1.w = __builtin_bit_cast(float, w.w & 0xffff0000u); }
                    const f32x4 o0 = s0 + g[bj][0] * acc[ai][bj][m][0], o1 = s1 + g[bj][1] * acc[ai][bj][m][1];
                    u32x4 ow; ow.x = pk2(o0.x, o0.y); ow.y = pk2(o0.z, o0.w); ow.z = pk2(o1.x, o1.y); ow.w = pk2(o1.z, o1.w);
                    *(u32x4*)(dp + bj * 128) = ow;
                }
            }
    }
};

struct EpiEvenIn {
    static constexpr bool PERM = true, AFTER_DRAIN = false;
    bf16_t *U, *Q, *K, *VT;
    __device__ __forceinline__ void operator()(const f32x4 (&acc)[2][2][4][2], const pg8::Unit& u, int wr, int wc, int fr_, int fq_) const {
        int fr = fr_, fq = fq_; asm volatile("" : "+v"(fr), "+v"(fq));
        const int row0 = u.pm * 256 + wr * 64 + fr;
        const int pn = u.pn;
        if (pn < 6) {
            const int col0 = pn * 256 + wc * 32 + 8 * fq;
#pragma unroll
            for (int ai = 0; ai < 2; ++ai)
#pragma unroll
                for (int m = 0; m < 4; ++m) {
                    const int row = row0 + ai * 128 + m * 16;
                    bf16_t* base; size_t cs;
                    if (row < ML) { base = U + (size_t)(row >> 13) * 1536 * 8192 + (row & 8191); cs = 8192; }
                    else { const int rr = row - ML; base = U + (size_t)4 * 1536 * 8192 + (size_t)(rr >> 8) * 1536 * 256 + (rr & 255); cs = 256; }
#pragma unroll
                    for (int bj = 0; bj < 2; ++bj) {
                        bf16_t* cpn = base + (size_t)(col0 + bj * 128) * cs;
                        const f32x4 v0 = acc[ai][bj][m][0], v1 = acc[ai][bj][m][1];
                        const unsigned w0 = pk2(v0[0], v0[1]), w1 = pk2(v0[2], v0[3]), w2 = pk2(v1[0], v1[1]), w3 = pk2(v1[2], v1[3]);
                        cpn[0] = (bf16_t)w0; cpn[cs] = (bf16_t)(w0 >> 16); cpn[2 * cs] = (bf16_t)w1; cpn[3 * cs] = (bf16_t)(w1 >> 16);
                        cpn[4 * cs] = (bf16_t)w2; cpn[5 * cs] = (bf16_t)(w2 >> 16); cpn[6 * cs] = (bf16_t)w3; cpn[7 * cs] = (bf16_t)(w3 >> 16);
                    }
                }
        } else if (pn < 10) {
            const bool isq = pn < 8;
            bf16_t* O = isq ? Q : K;
            const int col0 = ((pn - 6) & 1) * 256 + wc * 32 + 8 * fq;
            const float osc = isq ? 0.18033688011112042f : 1.0f;
            const bool lat = (u.pm * 256) < ML;
            const float fbase = -(float)(8 * (fq & 1)) * 0.8304820237218406f;
            const float sgn = (fq < 2) ? -1.0f : 1.0f;
#pragma unroll
            for (int ai = 0; ai < 2; ++ai)
#pragma unroll
                for (int m = 0; m < 4; ++m) {
                    const int row = row0 + ai * 128 + m * 16;
                    const int t = row & 8191;
                    const float pos = (float)((wc & 1) ? (t & 63) : (t >> 6));
                    bf16_t* rowp = O + (size_t)row * 512 + col0;
                    float o0[8], o1[8];
#pragma unroll
                    for (int e = 0; e < 8; ++e) {
                        float rv = pos * (__builtin_amdgcn_exp2f(fbase - (float)e * 0.8304820237218406f) * 0.15915494309189535f); rv = rv - floorf(rv);
                        const float cs = lat ? cos_rev(rv) : 1.0f, sn = (lat ? sin_rev(rv) : 0.0f) * sgn;
                        const float va = acc[ai][0][m][e >> 2][e & 3], vb = acc[ai][1][m][e >> 2][e & 3];
                        const float pa = shflx(va, 32, fq * 16 + fr), pb = shflx(vb, 32, fq * 16 + fr);
                        o0[e] = (va * cs + pa * sn) * osc; o1[e] = (vb * cs + pb * sn) * osc;
                    }
                    { u32x4 w; w.x = pk2(o0[0], o0[1]); w.y = pk2(o0[2], o0[3]); w.z = pk2(o0[4], o0[5]); w.w = pk2(o0[6], o0[7]); *(u32x4*)(rowp) = w; }
                    { u32x4 w; w.x = pk2(o1[0], o1[1]); w.y = pk2(o1[2], o1[3]); w.z = pk2(o1[4], o1[5]); w.w = pk2(o1[6], o1[7]); *(u32x4*)(rowp + 128) = w; }
                }
        } else {
#pragma unroll
            for (int ai = 0; ai < 2; ++ai)
#pragma unroll
                for (int m = 0; m < 4; ++m) {
                    const int row = row0 + ai * 128 + m * 16;
                    int b, key;
                    if (row < ML) { b = row >> 13; key = row & 8191; } else { const int rr = row - ML; b = rr >> 8; key = 8192 + (rr & 255); }
#pragma unroll
                    for (int bj = 0; bj < 2; ++bj) {
                        const int hh = (pn - 10) * 2 + bj;
                        bf16_t* vp = VT + ((size_t)(b * 4 + hh) * 128 + wc * 32 + 8 * fq) * NKEY + key;
#pragma unroll
                        for (int x = 0; x < 4; ++x) { vp[(size_t)x * NKEY] = (bf16_t)f2bf(acc[ai][bj][m][0][x]); vp[(size_t)(4 + x) * NKEY] = (bf16_t)f2bf(acc[ai][bj][m][1][x]); }
                    }
                }
        }
    }
};

__device__ __forceinline__ void load_row16(const float* f32p, const bf16_t* b16p, int lane, float (&v)[16]) {
    if (f32p) {
#pragma unroll
        for (int j = 0; j < 2; ++j) { const f32x4 a0 = *(const f32x4*)(f32p + 8 * lane + 512 * j), a1 = *(const f32x4*)(f32p + 8 * lane + 512 * j + 4);
            v[8 * j] = a0.x; v[8 * j + 1] = a0.y; v[8 * j + 2] = a0.z; v[8 * j + 3] = a0.w; v[8 * j + 4] = a1.x; v[8 * j + 5] = a1.y; v[8 * j + 6] = a1.z; v[8 * j + 7] = a1.w; }
    } else {
#pragma unroll
        for (int j = 0; j < 2; ++j) { const u32x4 w = *(const u32x4*)(b16p + 8 * lane + 512 * j);
            v[8 * j] = __builtin_bit_cast(float, w.x << 16); v[8 * j + 1] = __builtin_bit_cast(float, w.x & 0xffff0000u); v[8 * j + 2] = __builtin_bit_cast(float, w.y << 16); v[8 * j + 3] = __builtin_bit_cast(float, w.y & 0xffff0000u);
            v[8 * j + 4] = __builtin_bit_cast(float, w.z << 16); v[8 * j + 5] = __builtin_bit_cast(float, w.z & 0xffff0000u); v[8 * j + 6] = __builtin_bit_cast(float, w.w << 16); v[8 * j + 7] = __builtin_bit_cast(float, w.w & 0xffff0000u); }
    }
}
__device__ __forceinline__ void norm_rows(const float* srcLat, const float* srcCtx, const bf16_t* HLat, const bf16_t* HCtx, const float* g, const float* mods, int shOff, int scOff, bf16_t* A, int nrows, int gw, int ngw, int lane) {
    for (int row = gw; row < nrows; row += ngw) {
        const float* md = mods + (row < ML ? (row >> 13) : 4) * 6144;
        const size_t off = (row < ML) ? (size_t)row * 1024 : (size_t)(row - ML) * 1024;
        float v[16];
        load_row16(srcLat ? ((row < ML) ? srcLat : srcCtx) + off : nullptr, ((row < ML) ? HLat : HCtx) + off, lane, v);
        float ss = 0.f;
#pragma unroll
        for (int e = 0; e < 16; ++e) ss += v[e] * v[e];
        ss = wave_sum(ss, lane);
        const float rstd = rsqrtf(ss * (1.0f / 1024.0f) + 1e-6f);
#pragma unroll
        for (int j = 0; j < 2; ++j) {
            const int k = 8 * lane + 512 * j;
            float y[8];
#pragma unroll
            for (int hq = 0; hq < 2; ++hq) {
                const f32x4 gg = *(const f32x4*)(g + k + 4 * hq), sc = *(const f32x4*)(md + scOff + k + 4 * hq), sh = *(const f32x4*)(md + shOff + k + 4 * hq);
                y[4 * hq] = v[8 * j + 4 * hq] * rstd * gg.x * (sc.x + 1.0f) + sh.x; y[4 * hq + 1] = v[8 * j + 4 * hq + 1] * rstd * gg.y * (sc.y + 1.0f) + sh.y;
                y[4 * hq + 2] = v[8 * j + 4 * hq + 2] * rstd * gg.z * (sc.z + 1.0f) + sh.z; y[4 * hq + 3] = v[8 * j + 4 * hq + 3] * rstd * gg.w * (sc.w + 1.0f) + sh.w;
            }
            u32x4 w; w.x = pk2(y[0], y[1]); w.y = pk2(y[2], y[3]); w.z = pk2(y[4], y[5]); w.w = pk2(y[6], y[7]);
            *(u32x4*)(A + (size_t)row * 1024 + k) = w;
        }
    }
}
__device__ __forceinline__ void final_norm(const bf16_t* Hs, float* out, const float* g, int gw, int ngw, int lane) {
    for (int row = gw; row < ML; row += ngw) {
        float v[16];
        load_row16(nullptr, Hs + (size_t)row * 1024, lane, v);
        float ss = 0.f;
#pragma unroll
        for (int e = 0; e < 16; ++e) ss += v[e] * v[e];
        ss = wave_sum(ss, lane);
        const float rstd = rsqrtf(ss * (1.0f / 1024.0f) + 1e-6f);
        float* dst = out + (size_t)row * 1024;
#pragma unroll
        for (int j = 0; j < 2; ++j)
#pragma unroll
            for (int hq = 0; hq < 2; ++hq) {
                const int k = 8 * lane + 512 * j + 4 * hq; const f32x4 gg = *(const f32x4*)(g + k);
                f32x4 y; y.x = v[8 * j + 4 * hq] * rstd * gg.x; y.y = v[8 * j + 4 * hq + 1] * rstd * gg.y; y.z = v[8 * j + 4 * hq + 2] * rstd * gg.z; y.w = v[8 * j + 4 * hq + 3] * rstd * gg.w;
                *(f32x4*)(dst + k) = y;
            }
    }
}

__device__ __forceinline__ void transpose_item(const float* W, int K, int N, bf16_t* WT, LAS float* scr, int item, int lane) {
    const int nblk = N / 32, kb = item / nblk, nb = item % nblk, k0 = 64 * kb, n0 = 32 * nb;
#pragma unroll 8
    for (int i = 0; i < 32; ++i) { const int kk = 2 * i + (lane >> 5); scr[kk * 33 + (lane & 31)] = W[(size_t)(k0 + kk) * N + n0 + (lane & 31)]; }
    asm volatile("s_waitcnt lgkmcnt(0)" ::: "memory");
    const int c = lane & 7;
#pragma unroll
    for (int j = 0; j < 4; ++j) {
        const int n = (lane >> 3) + 8 * j; const LAS float* s = scr + (8 * c) * 33 + n;
        u32x4 o; o.x = pk2(s[0 * 33], s[1 * 33]); o.y = pk2(s[2 * 33], s[3 * 33]); o.z = pk2(s[4 * 33], s[5 * 33]); o.w = pk2(s[6 * 33], s[7 * 33]);
        *(u32x4*)(WT + (size_t)(n0 + n) * K + k0 + 8 * c) = o;
    }
    asm volatile("s_waitcnt lgkmcnt(0)" ::: "memory");
}
#define XB_TMO      128
#define XB_XCNT(j)  (256  + 64 * (j))
#define XB_XSUB(j)  (1280 + 64 * (j))
#define XB_XGEN(j)  (2304 + 64 * (j))
#define XB_TOP      3328
#define XB_TOPGEN   3392
#define XCD_BAR_WORDS 3456
#define XB_SPIN_CAP (1u << 18)

__device__ __forceinline__ unsigned xb_ld(unsigned* p)              { return __hip_atomic_load(p, __ATOMIC_RELAXED, __HIP_MEMORY_SCOPE_AGENT); }
__device__ __forceinline__ unsigned xb_add(unsigned* p, unsigned v) { return __hip_atomic_fetch_add(p, v, __ATOMIC_RELAXED, __HIP_MEMORY_SCOPE_AGENT); }
__device__ __forceinline__ unsigned xb_xcc_id() { return (unsigned)__builtin_amdgcn_s_getreg((3 << 11) | 20) & 0xFu; }
#define XB_SPIN(cond, bar) do { unsigned _sp = 0; while (cond) { __builtin_amdgcn_s_sleep(1); \
    if ((++_sp & 255u) == 0u) { if (xb_ld(&(bar)[XB_TMO])) break; if (_sp > XB_SPIN_CAP) { atomicAdd(&(bar)[XB_TMO], 1u); break; } } } } while (0)

struct XcdBarrier {
    unsigned* bar; unsigned x;
    volatile LAS unsigned* st;
};

__device__ __forceinline__ XcdBarrier xcd_barrier_post(unsigned* bar, volatile LAS unsigned* st) {
    XcdBarrier b; b.bar = bar; b.x = xb_xcc_id(); b.st = st;
    if (threadIdx.x == 0) (void)xb_add(&bar[XB_XCNT(b.x)], 1u);
    return b;
}
__device__ __forceinline__ void xcd_barrier_complete(unsigned* bar, unsigned x, unsigned& nloc, unsigned& nx) {
    const unsigned G = gridDim.x * gridDim.y * gridDim.z;
    unsigned sum, cnt, mine, sp = 0u;
    for (;;) {
        sum = 0u; cnt = 0u; mine = 0u;
#pragma unroll 1
        for (unsigned j = 0; j < 16; ++j) { const unsigned c = xb_ld(&bar[XB_XCNT(j)]); sum += c; cnt += (c > 0u) ? 1u : 0u; mine = (j == x) ? c : mine; }
        if (sum == G) break;
        __builtin_amdgcn_s_sleep(1);
        if ((++sp & 255u) == 0u) { if (xb_ld(&bar[XB_TMO])) break; if (sp > XB_SPIN_CAP) { atomicAdd(&bar[XB_TMO], 1u); break; } }
    }
    nloc = mine > 0u ? mine : 1u; nx = cnt > 0u ? cnt : 1u;
}

__device__ __forceinline__ void xcd_barrier(const XcdBarrier& b) {
    asm volatile("s_waitcnt vmcnt(0)" ::: "memory");
    __syncthreads();
    if (threadIdx.x == 0) {
        unsigned* bar = b.bar;
        __builtin_amdgcn_s_waitcnt(0);
        unsigned nloc = b.st[0], nx = b.st[1];
        if (nloc == 0u) { xcd_barrier_complete(bar, b.x, nloc, nx); b.st[0] = nloc; b.st[1] = nx; }
        const unsigned old = xb_add(&bar[XB_XSUB(b.x)], 1u);
        const unsigned gen = old / nloc;
        if (old + 1u == (gen + 1u) * nloc) {
            __builtin_amdgcn_fence(__ATOMIC_RELEASE, "agent");
            asm volatile("s_waitcnt vmcnt(0)" ::: "memory");
            const unsigned og = xb_add(&bar[XB_TOP], 1u);
            const unsigned tg = og / nx;
            if (og + 1u == (tg + 1u) * nx) xb_add(&bar[XB_TOPGEN], 1u);
            else XB_SPIN(xb_ld(&bar[XB_TOPGEN]) == tg, bar);
            __builtin_amdgcn_fence(__ATOMIC_ACQUIRE, "agent");
            xb_add(&bar[XB_XGEN(b.x)], 1u);
            asm volatile("s_waitcnt vmcnt(0)" ::: "memory");
        } else {
            XB_SPIN(xb_ld(&bar[XB_XGEN(b.x)]) == gen, bar);
            __builtin_amdgcn_fence(__ATOMIC_ACQUIRE, "agent");
            asm volatile("s_waitcnt vmcnt(0)" ::: "memory");
        }
    }
    __syncthreads();
}

struct KArgs { const float* in[38]; float* out; unsigned char* ws; int ph_lo, ph_hi; };
typedef const __attribute__((address_space(4))) KArgs& KArgsR;
typedef const __attribute__((address_space(4))) KArgs* KArgsP;
__device__ __forceinline__ KArgsP opaque_kargs(KArgsP p) {
    const unsigned long long v = (unsigned long long)p; unsigned lo = (unsigned)v, hi = (unsigned)(v >> 32);
    asm volatile("" : "+s"(lo), "+s"(hi));
    lo = __builtin_amdgcn_readfirstlane(lo); hi = __builtin_amdgcn_readfirstlane(hi);
    return (KArgsP)(((unsigned long long)hi << 32) | lo);
}

__device__ __forceinline__ void p0_phase(KArgsR a, LAS unsigned char* lds, int tid, int lane, int wid) {
    const int G = gridDim.x, bid = blockIdx.x;
    const int gw = bid * 8 + wid, ngw = G * 8;
    {
        LAS float* sl = (LAS float*)(lds + 69632);
        LAS float* red = (LAS float*)(lds + 90112);
        const float* c = a.in[1]; const float* cctx = a.in[3]; const float* ada_w = a.in[4]; const float* ada_b = a.in[5];
        float* MODS = (float*)(a.ws + WS_MODS);
        for (int idx = tid; idx < 5 * 1024; idx += NTHR) { const int s = idx >> 10, k = idx & 1023; const float x = s < 4 ? c[s * 1024 + k] : cctx[k]; sl[idx] = x / (1.0f + __expf(-x)); }
        __syncthreads();
        for (int item = bid; item < 384; item += G) {
            const int i = item / 96, cgp = item % 96;
            const float* W = ada_w + (size_t)i * 1024 * 6144 + cgp * 64 + lane;
            float acc[5] = {0.f, 0.f, 0.f, 0.f, 0.f};
            const int k0 = wid * 128;
#pragma unroll 8
            for (int kk = 0; kk < 128; ++kk) {
                const float w = W[(size_t)(k0 + kk) * 6144];
#pragma unroll
                for (int s = 0; s < 5; ++s) acc[s] += sl[s * 1024 + k0 + kk] * w;
            }
#pragma unroll
            for (int s = 0; s < 5; ++s) red[(wid * 5 + s) * 64 + lane] = acc[s];
            __syncthreads();
            if (tid < 320) {
                const int s = tid >> 6, l = tid & 63; float sum = ada_b[i * 6144 + cgp * 64 + l];
#pragma unroll
                for (int w = 0; w < 8; ++w) sum += red[(w * 5 + s) * 64 + l];
                MODS[(size_t)(i * 5 + s) * 6144 + cgp * 64 + l] = sum;
            }
            __syncthreads();
        }
    }
    {
        LAS float* scr = (LAS float*)(lds + wid * 8448);
        bf16_t* WB = (bf16_t*)(a.ws + WS_WB);
        for (int mi = 0; mi < 16; ++mi) {
            const float* W; int K, N; bf16_t* WT;
            if (mi < 4)       { W = a.in[8]  + (size_t)mi * 1024 * 4096;        K = 1024; N = 4096; WT = WB + WB_W1 + (size_t)mi * 4096 * 1024; }
            else if (mi < 8)  { W = a.in[9]  + (size_t)(mi - 4) * 4096 * 1024;  K = 4096; N = 1024; WT = WB + WB_W2 + (size_t)(mi - 4) * 4096 * 1024; }
            else if (mi < 10) { W = a.in[11] + (size_t)(mi - 8) * 1024 * 3072;  K = 1024; N = 3072; WT = WB + WB_EVIN + (size_t)(mi - 8) * 3072 * 1024; }
            else if (mi < 12) { W = a.in[12] + (size_t)(mi - 10) * 1024 * 1024; K = 1024; N = 1024; WT = WB + WB_EVOUT + (size_t)(mi - 10) * 1024 * 1024; }
            else if (mi < 14) { W = a.in[29] + (size_t)(mi - 12) * 1024 * 2560; K = 1024; N = 2560; WT = WB + WB_ODIN + (size_t)(mi - 12) * 2560 * 1024; }
            else              { W = a.in[30] + (size_t)(mi - 14) * 1280 * 1024; K = 1280; N = 1024; WT = WB + WB_ODOUT + (size_t)(mi - 14) * 1024 * 1280; }
            const int nit = (K / 64) * (N / 32);
            for (int it = gw; it < nit; it += ngw) transpose_item(W, K, N, WT, scr, it, lane);
        }
    }
    {
        bf16_t* WSC = (bf16_t*)(a.ws + WS_WSC);
        for (int it = bid; it < 128; it += G) {
            const int mat = it & 1, jdn = it >> 1;
            const float* W = (mat ? a.in[35] : a.in[33]) + (size_t)jdn * 6400;
            bf16_t* O = WSC + (size_t)it * 7680;
            for (int idx = tid; idx < 7680; idx += NTHR) { const int dp = idx / 96, c = idx % 96; O[idx] = (bf16_t)f2bf(c < 80 ? W[c * 80 + dp] : 0.f); }
        }
    }
    {
        _Float16* H2 = (_Float16*)(a.ws + WS_H2);
        for (int rowi = gw; rowi < 2 * 8448; rowi += ngw) {
            const int j = rowi / 8448, p = rowi % 8448;
            const float* w1 = a.in[15] + j * 33 * 64; const float* b1 = a.in[16] + j * 64; const float* w2 = a.in[17] + j * 64 * 64; const float* b2 = a.in[18] + j * 64;
            const float fq = a.in[21][j * 64 + lane];
            int pp, L; if (p < 8192) { pp = p; L = 8192; } else { pp = p - 8192; L = 256; }
            const float invL = 1.0f / (float)L;
            const float t = (float)pp * invL;
            float z = b1[lane] + t * w1[lane];
#pragma unroll 4
            for (int n = 1; n <= 16; ++n) {
                const float rv = (float)((pp * n) & (L - 1)) * invL;
                z += cos_rev(rv) * w1[n * 64 + lane] + sin_rev(rv) * w1[(16 + n) * 64 + lane];
            }
            const float h1 = fsin(fq * z);
            float z2 = b2[lane];
#pragma unroll 8
            for (int k = 0; k < 64; ++k) z2 += __builtin_bit_cast(float, __builtin_amdgcn_readlane(__builtin_bit_cast(int, h1), k)) * w2[k * 64 + lane];
            H2[(size_t)rowi * 64 + lane] = (_Float16)fsin(fq * z2);
        }
    }
}

__device__ __forceinline__ cf2 cmul(cf2 a, cf2 b) { return MKCF(a.x * b.x - a.y * b.y, a.x * b.y + a.y * b.x); }
__device__ __forceinline__ void fft_fwd(LAS cf2* X, int tid) {
#pragma unroll 1
    for (int s = 0; s < 7; ++s) {
        const int lq = 12 - 2 * s, q = 1 << lq;
        const float rs = __builtin_bit_cast(float, (unsigned)(127 - (lq + 2)) << 23);
        if (lq > 9) {
#pragma unroll 2
            for (int i = 0; i < 8; ++i) {
                const int bf = tid + NTHR * i, j = bf & (q - 1), i0 = ((bf >> lq) << (lq + 2)) + j;
                const cf2 x0 = X[i0], x1 = X[i0 + q], x2 = X[i0 + 2 * q], x3 = X[i0 + 3 * q];
                const float rv = (float)j * rs;
                const cf2 w1 = MKCF(cos_rev(rv), -sin_rev(rv)), w2 = cmul(w1, w1), w3 = cmul(w2, w1);
                const cf2 A = MKCF(x0.x + x2.x, x0.y + x2.y), B = MKCF(x0.x - x2.x, x0.y - x2.y), C = MKCF(x1.x + x3.x, x1.y + x3.y), D = MKCF(x1.x - x3.x, x1.y - x3.y);
                X[i0] = MKCF(A.x + C.x, A.y + C.y);
                X[i0 + q] = cmul(MKCF(B.x + D.y, B.y - D.x), w1);
                X[i0 + 2 * q] = cmul(MKCF(A.x - C.x, A.y - C.y), w2);
                X[i0 + 3 * q] = cmul(MKCF(B.x - D.y, B.y + D.x), w3);
            }
        } else {
            const int j = tid & (q - 1);
            const float rv = (float)j * rs;
            const cf2 w1 = MKCF(cos_rev(rv), -sin_rev(rv)), w2 = cmul(w1, w1), w3 = cmul(w2, w1);
#pragma unroll 4
            for (int i = 0; i < 8; ++i) {
                const int bf = tid + NTHR * i, i0 = ((bf >> lq) << (lq + 2)) + j;
                const cf2 x0 = X[i0], x1 = X[i0 + q], x2 = X[i0 + 2 * q], x3 = X[i0 + 3 * q];
                const cf2 A = MKCF(x0.x + x2.x, x0.y + x2.y), B = MKCF(x0.x - x2.x, x0.y - x2.y), C = MKCF(x1.x + x3.x, x1.y + x3.y), D = MKCF(x1.x - x3.x, x1.y - x3.y);
                X[i0] = MKCF(A.x + C.x, A.y + C.y);
                X[i0 + q] = cmul(MKCF(B.x + D.y, B.y - D.x), w1);
                X[i0 + 2 * q] = cmul(MKCF(A.x - C.x, A.y - C.y), w2);
                X[i0 + 3 * q] = cmul(MKCF(B.x - D.y, B.y + D.x), w3);
            }
        }
        __syncthreads();
    }
}
__device__ __forceinline__ void fft_inv(LAS cf2* X, int tid) {
#pragma unroll 1
    for (int s = 6; s >= 0; --s) {
        const int lq = 12 - 2 * s, q = 1 << lq;
        const float rs = __builtin_bit_cast(float, (unsigned)(127 - (lq + 2)) << 23);
        if (lq > 9) {
#pragma unroll 2
            for (int i = 0; i < 8; ++i) {
                const int bf = tid + NTHR * i, j = bf & (q - 1), i0 = ((bf >> lq) << (lq + 2)) + j;
                const float rv = (float)j * rs;
                const cf2 w1 = MKCF(cos_rev(rv), sin_rev(rv)), w2 = cmul(w1, w1), w3 = cmul(w2, w1);
                const cf2 u0 = X[i0], u1 = cmul(X[i0 + q], w1), u2 = cmul(X[i0 + 2 * q], w2), u3 = cmul(X[i0 + 3 * q], w3);
                const cf2 A = MKCF(u0.x + u2.x, u0.y + u2.y), B = MKCF(u0.x - u2.x, u0.y - u2.y), C = MKCF(u1.x + u3.x, u1.y + u3.y), D = MKCF(u1.x - u3.x, u1.y - u3.y);
                X[i0] = MKCF(A.x + C.x, A.y + C.y);
                X[i0 + q] = MKCF(B.x - D.y, B.y + D.x);
                X[i0 + 2 * q] = MKCF(A.x - C.x, A.y - C.y);
                X[i0 + 3 * q] = MKCF(B.x + D.y, B.y - D.x);
            }
        } else {
            const int j = tid & (q - 1);
            const float rv = (float)j * rs;
            const cf2 w1 = MKCF(cos_rev(rv), sin_rev(rv)), w2 = cmul(w1, w1), w3 = cmul(w2, w1);
#pragma unroll 4
            for (int i = 0; i < 8; ++i) {
                const int bf = tid + NTHR * i, i0 = ((bf >> lq) << (lq + 2)) + j;
                const cf2 u0 = X[i0], u1 = cmul(X[i0 + q], w1), u2 = cmul(X[i0 + 2 * q], w2), u3 = cmul(X[i0 + 3 * q], w3);
                const cf2 A = MKCF(u0.x + u2.x, u0.y + u2.y), B = MKCF(u0.x - u2.x, u0.y - u2.y), C = MKCF(u1.x + u3.x, u1.y + u3.y), D = MKCF(u1.x - u3.x, u1.y - u3.y);
                X[i0] = MKCF(A.x + C.x, A.y + C.y);
                X[i0 + q] = MKCF(B.x - D.y, B.y + D.x);
                X[i0 + 2 * q] = MKCF(A.x - C.x, A.y - C.y);
                X[i0 + 3 * q] = MKCF(B.x + D.y, B.y - D.x);
            }
        }
        __syncthreads();
    }
}
__device__ __forceinline__ void mul_spectrum(LAS cf2* X, const unsigned* KH, float bias, int tid) {
#pragma unroll 4
    for (int i = 0; i < 32; ++i) {
        const int p = tid + NTHR * i;
        const h16x2 kh = __builtin_bit_cast(h16x2, KH[p]);
        X[p] = cmul(X[p], MKCF((float)kh.x + bias, (float)kh.y));
    }
    __syncthreads();
}

typedef _Float16 f16x8 __attribute__((ext_vector_type(8)));
__device__ __forceinline__ int rev4_14(int x) { const unsigned r = __builtin_bitreverse32((unsigned)x) >> 18; return (int)(((r & 0x2AAAu) >> 1) | ((r & 0x1555u) << 1)); }
__device__ __forceinline__ void khat_item(KArgsR a, LAS unsigned char* lds, int j, int c, int tid) {
    LAS cf2* X = (LAS cf2*)lds; LAS float* Xf = (LAS float*)lds;
    const int lane = tid & 63, wid = tid >> 6, r = lane & 31, h = lane >> 5;
    const float* w3 = a.in[19] + (size_t)j * 64 * 2048; const float* b3 = a.in[20] + j * 2048; const float* decay = a.in[22] + (size_t)j * 2048;
    const _Float16* H2 = (const _Float16*)(a.ws + WS_H2) + (size_t)j * 8448 * 64;
    unsigned* KH = (unsigned*)(a.ws + WS_BIG + BIG_KH);
    const int o = (r >> 1) & 1, dir = r & 1;
    const int col = o * 1024 + dir * 512 + c;
    f16x8 bfr[4];
#pragma unroll
    for (int ks = 0; ks < 4; ++ks)
#pragma unroll
        for (int jj = 0; jj < 8; ++jj) bfr[ks][jj] = (r < 4) ? (_Float16)w3[(size_t)(16 * ks + 8 * h + jj) * 2048 + col] : (_Float16)0.f;
    const float bb = b3[col], dsc = fabsf(decay[col]) * (1.4426950408889634f / 8192.0f);
    if (tid == 0) X[8192] = MKCF(0.f, 0.f);
#pragma unroll 4
    for (int ti = 0; ti < 32; ++ti) {
        const int tl = wid + 8 * ti;
        f32x16 acc;
#pragma unroll
        for (int i = 0; i < 16; ++i) acc[i] = 0.f;
#pragma unroll
        for (int ks = 0; ks < 4; ++ks) {
            const f16x8 af = *(const f16x8*)(H2 + (size_t)(32 * tl + r) * 64 + 16 * ks + 8 * h);
            acc = __builtin_amdgcn_mfma_f32_32x32x16_f16(af, bfr[ks], acc, 0, 0, 0);
        }
        if (r < 4) {
#pragma unroll
            for (int i = 0; i < 16; ++i) {
                const int p = 32 * tl + (i & 3) + 8 * (i >> 2) + 4 * h;
                const float val = (acc[i] + bb) * __builtin_amdgcn_exp2f(-(float)p * dsc);
                if (dir == 0) Xf[2 * p + o] = val;
                else if (p != 0) Xf[2 * (16384 - p) + o] = val;
            }
        }
    }
    __syncthreads();
    fft_fwd(X, tid);
#pragma unroll 4
    for (int i = 0; i < 32; ++i) {
        const int p = tid + NTHR * i;
        const int k = rev4_14(p), pm = rev4_14((16384 - k) & 16383);
        const cf2 z = X[p], zm = X[pm];
        h16x2 k0, k1;
        k0.x = (_Float16)(0.5f * (z.x + zm.x)); k0.y = (_Float16)(0.5f * (z.y - zm.y));
        k1.x = (_Float16)(0.5f * (z.y + zm.y)); k1.y = (_Float16)(0.5f * (zm.x - z.x));
        KH[(size_t)c * 16384 + p] = __builtin_bit_cast(unsigned, k0);
        KH[(size_t)(512 + c) * 16384 + p] = __builtin_bit_cast(unsigned, k1);
    }
    __syncthreads();
}

__device__ __forceinline__ float conv3_at(const bf16_t* p, int t, float w0, float w1, float w2, float bs) {
    const float l = t > 0 ? bf2f(p[t - 1]) : 0.f, m = bf2f(p[t]), r = t < 8191 ? bf2f(p[t + 1]) : 0.f;
    return w0 * l + w1 * m + w2 * r + bs;
}
__device__ __forceinline__ void conv3_pair(const bf16_t* p, int t2, float w0, float w1, float w2, float bs, float (&o)[2]) {
    const unsigned wm = *(const unsigned*)(p + t2);
    const unsigned wl = t2 > 0 ? *(const unsigned*)(p + t2 - 2) : 0u, wr = t2 < 8190 ? *(const unsigned*)(p + t2 + 2) : 0u;
    const float xm1 = __builtin_bit_cast(float, wl & 0xffff0000u), x0 = __builtin_bit_cast(float, wm << 16), x1 = __builtin_bit_cast(float, wm & 0xffff0000u), x2 = __builtin_bit_cast(float, wr << 16);
    o[0] = w0 * xm1 + w1 * x0 + w2 * x1 + bs; o[1] = w0 * x0 + w1 * x1 + w2 * x2 + bs;
}
__device__ __forceinline__ void hyena_lat_item(KArgsR a, LAS unsigned char* lds, int j, int c, int pair, int tid) {
    LAS cf2* X = (LAS cf2*)lds;
    const bf16_t* UT = (const bf16_t*)(a.ws + WS_BIG + BIG_U);
    const unsigned* KH = (const unsigned*)(a.ws + WS_BIG + BIG_KH);
    bf16_t* ACT = (bf16_t*)(a.ws + WS_ACT);
    const float* sw = a.in[13] + (size_t)j * 3 * 1536; const float* sb = a.in[14] + j * 1536; const float* hbias = a.in[23] + j * 1024;
    const int b0 = 2 * pair;
    const bf16_t* V0 = UT + ((size_t)b0 * 1536 + c) * 8192; const bf16_t* V1 = V0 + (size_t)1536 * 8192;
    const float wv0 = sw[c], wv1 = sw[1536 + c], wv2 = sw[3072 + c], bv = sb[c];
    const float wa0 = sw[512 + c], wa1 = sw[1536 + 512 + c], wa2 = sw[3072 + 512 + c], ba_ = sb[512 + c];
    const float wb0 = sw[1024 + c], wb1 = sw[1536 + 1024 + c], wb2 = sw[3072 + 1024 + c], bb_ = sb[1024 + c];
    const float bias0 = hbias[c], bias1 = hbias[512 + c];
#pragma unroll 4
    for (int i = 0; i < 8; ++i) {
        const int t2 = 2 * tid + 1024 * i;
        const unsigned w0 = *(const unsigned*)(V0 + t2), w1 = *(const unsigned*)(V1 + t2);
        f32x4 o; o.x = __builtin_bit_cast(float, w0 << 16); o.y = __builtin_bit_cast(float, w1 << 16); o.z = __builtin_bit_cast(float, w0 & 0xffff0000u); o.w = __builtin_bit_cast(float, w1 & 0xffff0000u);
        *(LAS f32x4*)(X + t2) = o;
    }
    __syncthreads();
#pragma unroll 2
    for (int i = 0; i < 16; ++i) {
        const int t = tid + NTHR * i;
        const cf2 l = t > 0 ? X[t - 1] : MKCF(0.f, 0.f), m = X[t], r = t < 8191 ? X[t + 1] : MKCF(0.f, 0.f);
        X[8192 + t] = MKCF(wv0 * l.x + wv1 * m.x + wv2 * r.x + bv, wv0 * l.y + wv1 * m.y + wv2 * r.y + bv);
    }
    __syncthreads();
#pragma unroll 2
    for (int i = 0; i < 16; ++i) { const int t = tid + NTHR * i; X[t] = X[8192 + t]; X[8192 + t] = MKCF(0.f, 0.f); }
    __syncthreads();
    fft_fwd(X, tid);
    mul_spectrum(X, KH + (size_t)c * 16384, bias0, tid);
    fft_inv(X, tid);
    {
        const bf16_t* A0 = V0 + (size_t)512 * 8192; const bf16_t* A1 = V1 + (size_t)512 * 8192;
#pragma unroll 2
        for (int i = 0; i < 8; ++i) {
            const int t2 = 2 * tid + 1024 * i;
            float xa[2], xb[2];
            conv3_pair(A0, t2, wa0, wa1, wa2, ba_, xa); conv3_pair(A1, t2, wa0, wa1, wa2, ba_, xb);
            const f32x4 y = *(const LAS f32x4*)(X + t2);
            f32x4 o; o.x = xa[0] * y.x * (1.0f / 16384.0f); o.y = xb[0] * y.y * (1.0f / 16384.0f); o.z = xa[1] * y.z * (1.0f / 16384.0f); o.w = xb[1] * y.w * (1.0f / 16384.0f);
            *(LAS f32x4*)(X + t2) = o; *(LAS f32x4*)(X + 8192 + t2) = (f32x4){0.f, 0.f, 0.f, 0.f};
        }
    }
    __syncthreads();
    fft_fwd(X, tid);
    mul_spectrum(X, KH + (size_t)(512 + c) * 16384, bias1, tid);
    fft_inv(X, tid);
    {
        const bf16_t* B0 = V0 + (size_t)1024 * 8192; const bf16_t* B1 = V1 + (size_t)1024 * 8192;
#pragma unroll 2
        for (int i = 0; i < 8; ++i) {
            const int t2 = 2 * tid + 1024 * i;
            float xa[2], xb[2];
            conv3_pair(B0, t2, wb0, wb1, wb2, bb_, xa); conv3_pair(B1, t2, wb0, wb1, wb2, bb_, xb);
            const f32x4 y = *(const LAS f32x4*)(X + t2);
            ACT[(size_t)(b0 * 8192 + t2) * 1024 + c] = (bf16_t)f2bf(xa[0] * y.x * (1.0f / 16384.0f));
            ACT[(size_t)((b0 + 1) * 8192 + t2) * 1024 + c] = (bf16_t)f2bf(xb[0] * y.y * (1.0f / 16384.0f));
            ACT[(size_t)(b0 * 8192 + t2 + 1) * 1024 + c] = (bf16_t)f2bf(xa[1] * y.z * (1.0f / 16384.0f));
            ACT[(size_t)((b0 + 1) * 8192 + t2 + 1) * 1024 + c] = (bf16_t)f2bf(xb[1] * y.w * (1.0f / 16384.0f));
        }
    }
    __syncthreads();
}

__device__ __forceinline__ void hyena_ctx_item(KArgsR a, LAS unsigned char* lds, int j, int c, int tid) {
    LAS float* ks = (LAS float*)lds;
    LAS float* vc = ks + 1024;
    LAS float* zc = vc + 1024;
    LAS float* w3c = zc + 1024;
    const bf16_t* U = (const bf16_t*)(a.ws + WS_BIG + BIG_U);
    bf16_t* ACT = (bf16_t*)(a.ws + WS_ACT);
    const float* w3 = a.in[19] + (size_t)j * 64 * 2048; const float* b3 = a.in[20] + j * 2048; const float* decay = a.in[22] + (size_t)j * 2048;
    const _Float16* H2 = (const _Float16*)(a.ws + WS_H2) + ((size_t)j * 8448 + 8192) * 64;
    const float* sw = a.in[13] + (size_t)j * 3 * 1536; const float* sb = a.in[14] + j * 1536; const float* hbias = a.in[23] + j * 1024;
    if (tid < 256) w3c[tid] = w3[(size_t)(tid & 63) * 2048 + (tid >> 6) * 512 + c];
    if (tid < 2) ks[tid * 512] = 0.f;
    __syncthreads();
    float x1c[2], x2c[2];
#pragma unroll
    for (int k = 0; k < 2; ++k) {
        const int idx = tid + NTHR * k;
        {
            const int od = idx >> 8, p = idx & 255, col = od * 512 + c, o = od >> 1, dir = od & 1;
            const f16x8* hr = (const f16x8*)(H2 + (size_t)p * 64); float dot = 0.f;
#pragma unroll
            for (int u8 = 0; u8 < 8; ++u8) { const f16x8 hv = hr[u8];
#pragma unroll
                for (int e = 0; e < 8; ++e) dot += (float)hv[e] * w3c[od * 64 + u8 * 8 + e]; }
            const float val = (dot + b3[col]) * __expf(-(float)p * (1.0f / 256.0f) * fabsf(decay[col]));
            if (dir == 0) ks[o * 512 + 256 + p] = val; else if (p != 0) ks[o * 512 + 256 - p] = val;
        }
        {
            const int b = idx >> 8, t = idx & 255;
            float cv[3];
#pragma unroll
            for (int g = 0; g < 3; ++g) {
                const int ch = g * 512 + c;
                const bf16_t* Ur = U + (size_t)4 * 1536 * 8192 + ((size_t)b * 1536 + ch) * 256 + t;
                const float l = t > 0 ? bf2f(Ur[-1]) : 0.f, m = bf2f(Ur[0]), r = t < 255 ? bf2f(Ur[1]) : 0.f;
                cv[g] = sw[ch] * l + sw[1536 + ch] * m + sw[3072 + ch] * r + sb[ch];
            }
            vc[idx] = cv[0]; x1c[k] = cv[1]; x2c[k] = cv[2];
        }
    }
    __syncthreads();
    const float bias0 = hbias[c], bias1 = hbias[512 + c];
#pragma unroll
    for (int k = 0; k < 2; ++k) {
        const int idx = tid + NTHR * k, b = idx >> 8, t = idx & 255;
        float y = 0.f;
        const LAS float* kp = ks + 256 + t; const LAS f32x4* vp = (const LAS f32x4*)(vc + b * 256);
#pragma unroll 4
        for (int s4 = 0; s4 < 64; ++s4) { const f32x4 v = vp[s4]; y += kp[-4 * s4] * v.x + kp[-4 * s4 - 1] * v.y + kp[-4 * s4 - 2] * v.z + kp[-4 * s4 - 3] * v.w; }
        zc[idx] = x1c[k] * (y + vc[idx] * bias0);
    }
    __syncthreads();
#pragma unroll
    for (int k = 0; k < 2; ++k) {
        const int idx = tid + NTHR * k, b = idx >> 8, t = idx & 255;
        float y = 0.f;
        const LAS float* kp = ks + 512 + 256 + t; const LAS f32x4* vp = (const LAS f32x4*)(zc + b * 256);
#pragma unroll 4
        for (int s4 = 0; s4 < 64; ++s4) { const f32x4 v = vp[s4]; y += kp[-4 * s4] * v.x + kp[-4 * s4 - 1] * v.y + kp[-4 * s4 - 2] * v.z + kp[-4 * s4 - 3] * v.w; }
        ACT[(size_t)(ML + b * 256 + t) * 1024 + c] = (bf16_t)f2bf(x2c[k] * (y + zc[idx] * bias1));
    }
    __syncthreads();
}

#define MFMA32(a_, b_, c_) __builtin_amdgcn_mfma_f32_32x32x16_bf16((a_), (b_), (c_), 0, 0, 0)
#define MFMA16(a_, b_, c_) __builtin_amdgcn_mfma_f32_16x16x32_bf16((a_), (b_), (c_), 0, 0, 0)
__device__ __forceinline__ void attn_unit(KArgsR a, LAS unsigned char* lds, int b, int hh, int qrow0, int kt_lo, int kt_hi, float lam, float osc, const float* subg, int tid) {
    const int lane = tid & 63, wid = tid >> 6, r = lane & 31, h = lane >> 5;
    const bf16_t* Qb = (const bf16_t*)(a.ws + WS_BIG + BIG_Q); const bf16_t* Kb = (const bf16_t*)(a.ws + WS_BIG + BIG_K); const bf16_t* VT = (const bf16_t*)(a.ws + WS_BIG + BIG_VT);
    bf16_t* ACT = (bf16_t*)(a.ws + WS_ACT);
    const int qrow = qrow0 + wid * 32 + r;
    LAS unsigned* osl = (LAS unsigned*)(lds + 53248) + wid * 2048 + lane;
    const int kkey = tid >> 3, kch = tid & 7;
    const bf16_t* vbase = VT + (size_t)((b * 4 + hh) * 128) * NKEY + (size_t)(tid >> 3) * NKEY + (tid & 7) * 8;
#define ATT_LOAD(KR, V0, V1, kt_) do { const int ktt_ = (kt_); const int kb_ = ktt_ < 128 ? b * 8192 + ktt_ * 64 : ML + b * 256 + (ktt_ - 128) * 64; \
        KR = *(const u32x4*)(kcol + (size_t)(kb_ + kkey) * 512); V0 = *(const u32x4*)(vbase + ktt_ * 64); V1 = *(const u32x4*)(vbase + (size_t)64 * NKEY + ktt_ * 64); } while (0)
#define ATT_STORE(KR, V0, V1, slot_) do { LAS unsigned char* ks_ = lds + (slot_) * 26624; LAS unsigned char* vs_ = ks_ + 9216 + (tid >> 3) * 136 + (tid & 7) * 16; \
        *(LAS u32x4*)(ks_ + kkey * 144 + kch * 16) = KR; \
        { u32x2 w0_, w1_; w0_.x = V0.x; w0_.y = V0.y; w1_.x = V0.z; w1_.y = V0.w; *(LAS u32x2*)(vs_) = w0_; *(LAS u32x2*)(vs_ + 8) = w1_; } \
        { u32x2 w0_, w1_; w0_.x = V1.x; w0_.y = V1.y; w1_.x = V1.z; w1_.y = V1.w; *(LAS u32x2*)(vs_ + 64 * 136) = w0_; *(LAS u32x2*)(vs_ + 64 * 136 + 8) = w1_; } } while (0)
#pragma unroll 1
    for (int jj = 0; jj < 2; ++jj) {
        const bf16_t* kcol = Kb + hh * 128 + jj * 64 + kch * 8;
        bf16x8 qf[4];
#pragma unroll
        for (int ks = 0; ks < 4; ++ks) qf[ks] = *(const bf16x8*)(Qb + (size_t)qrow * 512 + hh * 128 + jj * 64 + ks * 16 + h * 8);
        f32x16 o[4];
#pragma unroll
        for (int et = 0; et < 4; ++et)
#pragma unroll
            for (int i = 0; i < 16; ++i) o[et][i] = 0.f;
        float mrun = -INFINITY, lrun = 0.f;
        u32x4 kA, vA0, vA1, kB, vB0, vB1;
        ATT_LOAD(kA, vA0, vA1, kt_lo); ATT_LOAD(kB, vB0, vB1, kt_lo + 1);
        ATT_STORE(kA, vA0, vA1, 0);
        if (kt_lo + 2 < kt_hi) ATT_LOAD(kA, vA0, vA1, kt_lo + 2);
#pragma unroll 1
        for (int kt2 = kt_lo; kt2 < kt_hi; kt2 += 2) {
#pragma unroll
            for (int par = 0; par < 2; ++par) {
                __syncthreads();
                if (par == 0) { ATT_STORE(kB, vB0, vB1, 1); if (kt2 + 3 < kt_hi) ATT_LOAD(kB, vB0, vB1, kt2 + 3); }
                else { if (kt2 + 2 < kt_hi) { ATT_STORE(kA, vA0, vA1, 0); } if (kt2 + 4 < kt_hi) ATT_LOAD(kA, vA0, vA1, kt2 + 4); }
                const LAS unsigned char* Kl = lds + par * 26624; const LAS unsigned char* Vl = Kl + 9216;
                f32x16 s0, s1;
#pragma unroll
                for (int i = 0; i < 16; ++i) { s0[i] = 0.f; s1[i] = 0.f; }
#pragma unroll
                for (int ks = 0; ks < 4; ++ks) {
                    const bf16x8 k0 = *(const LAS bf16x8*)(Kl + r * 144 + (ks * 16 + h * 8) * 2);
                    const bf16x8 k1 = *(const LAS bf16x8*)(Kl + (32 + r) * 144 + (ks * 16 + h * 8) * 2);
                    s0 = MFMA32(k0, qf[ks], s0); s1 = MFMA32(k1, qf[ks], s1);
                }
                float mx = s0[0];
#pragma unroll
                for (int i = 0; i < 16; ++i) { mx = fmaxf(mx, s0[i]); mx = fmaxf(mx, s1[i]); }
                mx = fmaxf(mx, shflx(mx, 32, lane));
                const float mnew = fmaxf(mrun, mx);
                const float alpha = __builtin_amdgcn_exp2f(mrun - mnew);
                float sum = 0.f;
#pragma unroll
                for (int i = 0; i < 16; ++i) { s0[i] = __builtin_amdgcn_exp2f(s0[i] - mnew); s1[i] = __builtin_amdgcn_exp2f(s1[i] - mnew); sum += s0[i] + s1[i]; }
                sum += shflx(sum, 32, lane);
                lrun = lrun * alpha + sum; mrun = mnew;
                if (__builtin_amdgcn_ballot_w64(alpha != 1.0f) != 0ull) {
#pragma unroll
                    for (int et = 0; et < 4; ++et)
#pragma unroll
                        for (int i = 0; i < 16; ++i) o[et][i] *= alpha;
                }
                __builtin_amdgcn_sched_barrier(0);
#pragma unroll
                for (int st = 0; st < 2; ++st)
#pragma unroll
                    for (int s = 0; s < 2; ++s) {
                        u32x4 pw;
                        if (st == 0) { pw.x = pk2(s0[8 * s + 0], s0[8 * s + 1]); pw.y = pk2(s0[8 * s + 2], s0[8 * s + 3]); pw.z = pk2(s0[8 * s + 4], s0[8 * s + 5]); pw.w = pk2(s0[8 * s + 6], s0[8 * s + 7]); }
                        else         { pw.x = pk2(s1[8 * s + 0], s1[8 * s + 1]); pw.y = pk2(s1[8 * s + 2], s1[8 * s + 3]); pw.z = pk2(s1[8 * s + 4], s1[8 * s + 5]); pw.w = pk2(s1[8 * s + 6], s1[8 * s + 7]); }
                        const bf16x8 pf = __builtin_bit_cast(bf16x8, pw);
                        u32x4 vw[4];
#pragma unroll
                        for (int et = 0; et < 4; ++et) {
                            const LAS unsigned char* vp = Vl + (32 * et + r) * 136 + (32 * st + 16 * s + 4 * h) * 2;
                            const u32x2 lo = *(const LAS u32x2*)vp, hi = *(const LAS u32x2*)(vp + 16);
                            vw[et].x = lo.x; vw[et].y = lo.y; vw[et].z = hi.x; vw[et].w = hi.y;
                        }
                        __builtin_amdgcn_s_setprio(1);
#pragma unroll
                        for (int et = 0; et < 4; ++et) o[et] = MFMA32(__builtin_bit_cast(bf16x8, vw[et]), pf, o[et]);
                        __builtin_amdgcn_s_setprio(0);
                        if (st * 2 + s == 1) __builtin_amdgcn_sched_barrier(0);
                    }
            }
        }
        const float inv = 1.0f / lrun;
        if (jj == 0) {
#pragma unroll
            for (int et = 0; et < 4; ++et)
#pragma unroll
                for (int i = 0; i < 8; ++i) osl[(et * 8 + i) * 64] = pk2(o[et][2 * i] * inv, o[et][2 * i + 1] * inv);
        } else {
            float ss = 0.f;
#pragma unroll
            for (int et = 0; et < 4; ++et)
#pragma unroll
                for (int i = 0; i < 16; ++i) { const unsigned pw0 = osl[(et * 8 + (i >> 1)) * 64]; const float p0 = __builtin_bit_cast(float, (i & 1) ? (pw0 & 0xffff0000u) : (pw0 << 16)); const float v = p0 - lam * (o[et][i] * inv); o[et][i] = v; ss += v * v; }
            ss += shflx(ss, 32, lane);
            const float rstd = rsqrtf(ss * (1.0f / 128.0f) + 1e-6f) * osc;
#pragma unroll
            for (int et = 0; et < 4; ++et)
#pragma unroll
                for (int g = 0; g < 4; ++g) {
                    const int e = 32 * et + 8 * g + 4 * h;
                    const f32x4 sg = *(const f32x4*)(subg + e);
                    u32x2 w; w.x = pk2(o[et][4 * g] * rstd * sg.x, o[et][4 * g + 1] * rstd * sg.y); w.y = pk2(o[et][4 * g + 2] * rstd * sg.z, o[et][4 * g + 3] * rstd * sg.w);
                    *(u32x2*)(ACT + (size_t)qrow * 1024 + 512 + hh * 128 + e) = w;
                }
        }
        __syncthreads();
    }
#undef ATT_LOAD
#undef ATT_STORE
}

__device__ __forceinline__ int scan_seq(int d, int k) { return d == 0 ? k : (k < 4 ? 3 - k : 135 - k); }
__device__ __forceinline__ float fsigm(float x) { return __builtin_amdgcn_rcpf(1.0f + __builtin_amdgcn_exp2f(-1.4426950408889634f * x)); }
__device__ __forceinline__ float fgelu(float g) { const float u = 0.7978845608028654f * (g + 0.044715f * g * g * g); return 0.5f * g * (2.0f - 2.0f * __builtin_amdgcn_rcpf(1.0f + __builtin_amdgcn_exp2f(2.8853900817779268f * u))); }
__device__ __forceinline__ void scan_chain(KArgsR a, LAS unsigned char* lds, int j, int cid, int tid) {
    const int d = tid >> 8, ht = tid & 255, lane = tid & 63, hw = (tid >> 6) & 3;
    const int q4 = cid & 3, n = (cid >> 2) & 15, b = cid >> 6;
    const int ch0 = n * 80, cq0 = ch0 + q4 * 20;
    LAS unsigned char* hb = lds + d * 69120;
    LAS float* xraw = (LAS float*)hb; LAS bf16_t* xcb = (LAS bf16_t*)(hb + 21504); LAS bf16_t* Wl = (LAS bf16_t*)(hb + 33792);
    LAS float* al = (LAS float*)(hb + 46080); LAS float* bl = (LAS float*)(hb + 54784); LAS float* hl = (LAS float*)(hb + 63488);
    const bf16_t* XG = (const bf16_t*)(a.ws + WS_BIG); bf16_t* ACT = (bf16_t*)(a.ws + WS_ACT);
    const bf16_t* WSC = (const bf16_t*)(a.ws + WS_WSC) + (size_t)(((j * 2 + d) * 16 + n) * 2) * 7680;
    const float* convw = a.in[31] + (size_t)j * 4 * 1280; const float* convb = a.in[32] + j * 1280;
    const float* ba = a.in[34] + j * 2560 + d * 1280; const float* bx = a.in[36] + j * 2560 + d * 1280; const float* lamp = a.in[37] + j * 2560 + d * 1280;
    for (int idx = ht; idx < 2 * 32 * 12; idx += 256) {
        const int mat = idx / 384, rem = idx % 384, dpl = rem / 12, ck = rem % 12;
        u32x4 v = {0u, 0u, 0u, 0u};
        if (dpl < 20) v = *(const u32x4*)(WSC + (size_t)mat * 7680 + (q4 * 20 + dpl) * 96 + ck * 8);
        *(LAS u32x4*)(Wl + mat * 3072 + dpl * 96 + ck * 8) = v;
    }
    for (int idx = ht; idx < 64 * 16; idx += 256) xcb[(idx >> 4) * 96 + 80 + (idx & 15)] = 0;
    float bav[2], bxv[2], spv[2]; bool val[2];
#pragma unroll
    for (int nt = 0; nt < 2; ++nt) {
        const int dp = 16 * nt + (lane & 15); val[nt] = dp < 20; const int gc = cq0 + (val[nt] ? dp : 0);
        bav[nt] = ba[gc]; bxv[nt] = bx[gc]; spv[nt] = log1pf(__expf(-lamp[gc]));
    }
    const int xrow = (ht / 40) % 6, cp = ht % 40;
    const int tr = (ht / 20) % 12, cgp = ht % 20;
    f32x4 cw4[4], cb4;
#pragma unroll
    for (int kk = 0; kk < 4; ++kk) cw4[kk] = *(const f32x4*)(convw + kk * 1280 + ch0 + 4 * cgp);
    cb4 = *(const f32x4*)(convb + ch0 + 4 * cgp);
    float hcar = 0.f;
    const int sth = ht - 64 * d;
    int otab[3];
#pragma unroll
    for (int r = 0; r < 3; ++r) { const int e = ht + 256 * r; otab[r] = ((e / 10) << 8) | (2 * (e % 10)); }
    unsigned xr[12];
    const bf16_t* xcol = XG + 1280 + ch0 + 2 * cp;
#define SC_PARAMS(S_, T0_, LS_, RB_, kk_) do { const int s__ = scan_seq(d, (kk_)); S_ = s__; if (s__ < 4) { T0_ = s__ * 64; LS_ = 256; RB_ = ML + b * 256; } else { T0_ = (s__ - 4) * 64; LS_ = 8192; RB_ = b * 8192; } } while (0)
#define SC_PREFETCH(T0_, LS_, RB_) do { _Pragma("unroll") for (int p = 0; p < 12; ++p) { int tt = xrow + 6 * p; tt = tt > 66 ? 66 : tt; int t = (T0_) + tt - 2; t = t < 0 ? 0 : (t >= (LS_) ? (LS_) - 1 : t); \
        xr[p] = *(const unsigned*)(xcol + (size_t)((RB_) + t) * 2560); } } while (0)
#define SC_STAGE(T0_, LS_) do { _Pragma("unroll") for (int p = 0; p < 12; ++p) { int tt = xrow + 6 * p; tt = tt > 66 ? 66 : tt; const int t = (T0_) + tt - 2; const unsigned xv = (t >= 0 && t < (LS_)) ? xr[p] : 0u; \
        *(LAS cf2*)(xraw + tt * 80 + 2 * cp) = MKCF(__builtin_bit_cast(float, xv << 16), __builtin_bit_cast(float, xv & 0xffff0000u)); } } while (0)
#define SC_CONV do { _Pragma("unroll") for (int p = 0; p < 6; ++p) { int tt = tr + 12 * p; tt = tt > 63 ? 63 : tt; f32x4 v = cb4; \
        _Pragma("unroll") for (int kk = 0; kk < 4; ++kk) v += cw4[kk] * *(const LAS f32x4*)(xraw + (tt + kk) * 80 + 4 * cgp); \
        u32x2 w; w.x = pk2(v.x, v.y); w.y = pk2(v.z, v.w); *(LAS u32x2*)(xcb + tt * 96 + 4 * cgp) = w; if (p & 1) __builtin_amdgcn_sched_barrier(0); } } while (0)
    int sA, t0A, LsA, rbA, sB = 0, t0B = 0, LsB = 1, rbB = 0;
    SC_PARAMS(sA, t0A, LsA, rbA, 0); SC_PREFETCH(t0A, LsA, rbA); SC_STAGE(t0A, LsA);
    SC_PARAMS(sB, t0B, LsB, rbB, 1); SC_PREFETCH(t0B, LsB, rbB);
    __syncthreads();
    SC_CONV;
    __syncthreads();
#pragma unroll 1
    for (int k = 0; k < NCH; ++k) {
        if (k + 1 < NCH) SC_STAGE(t0B, LsB);
        int sC = 0, t0C = 0, LsC = 1, rbC = 0;
        if (k + 2 < NCH) { SC_PARAMS(sC, t0C, LsC, rbC, k + 2); SC_PREFETCH(t0C, LsC, rbC); }
        {
            const int mt = hw;
            f32x4 ra[2], ri[2];
#pragma unroll
            for (int nt = 0; nt < 2; ++nt) { ra[nt] = (f32x4){0.f, 0.f, 0.f, 0.f}; ri[nt] = (f32x4){0.f, 0.f, 0.f, 0.f}; }
#pragma unroll
            for (int ks = 0; ks < 3; ++ks) {
                const bf16x8 af = *(const LAS bf16x8*)(xcb + (16 * mt + (lane & 15)) * 96 + 32 * ks + 8 * (lane >> 4));
#pragma unroll
                for (int nt = 0; nt < 2; ++nt) {
                    const bf16x8 wfa = *(const LAS bf16x8*)(Wl + (16 * nt + (lane & 15)) * 96 + 32 * ks + 8 * (lane >> 4));
                    const bf16x8 wfx = *(const LAS bf16x8*)(Wl + 3072 + (16 * nt + (lane & 15)) * 96 + 32 * ks + 8 * (lane >> 4));
                    ra[nt] = MFMA16(af, wfa, ra[nt]); ri[nt] = MFMA16(af, wfx, ri[nt]);
                }
            }
#pragma unroll
            for (int nt = 0; nt < 2; ++nt) {
                {
                    const int dp = 16 * nt + (lane & 15), tb = 16 * mt + 4 * (lane >> 4);
                    f32x4 av4, bv4;
#pragma unroll
                    for (int i = 0; i < 4; ++i) {
                        const float rg = fsigm(ra[nt][i] + bav[nt]), ig = fsigm(ri[nt][i] + bxv[nt]);
                        const float la = -8.0f * rg * spv[nt];
                        const float av = __builtin_amdgcn_exp2f(1.4426950408889634f * la);
                        const float em = fmaxf(1.0f - av * av, 0.f);
                        av4[i] = av;
                        bv4[i] = __builtin_amdgcn_sqrtf(em) * ig * bf2f(xcb[(tb + i) * 96 + q4 * 20 + dp]);
                    }
                    *(LAS f32x4*)(al + dp * 68 + tb) = av4; *(LAS f32x4*)(bl + dp * 68 + tb) = bv4;
                }
            }
        }
        __syncthreads();
        const int kother = (d == 0) ? (sA < 4 ? 3 - sA : 135 - sA) : sA;
        const bool first = k < kother, early = (k - kother) >= 2;
        unsigned pvr[3] = {0u, 0u, 0u}, ggr[3] = {0u, 0u, 0u};
        if (early) {
#pragma unroll
            for (int r = 0; r < 3; ++r) {
                const int e = ht + 256 * r;
                if (e < 640) {
                    const int tt = otab[r] >> 8, dp = otab[r] & 255; const size_t row = (size_t)(rbA + t0A + tt);
                    pvr[r] = __hip_atomic_load((unsigned*)(ACT + row * 1280 + cq0 + dp), __ATOMIC_RELAXED, __HIP_MEMORY_SCOPE_AGENT);
                    ggr[r] = *(const unsigned*)(XG + row * 2560 + cq0 + dp);
                }
            }
        }
        if (sth >= 0 && sth < 20) {
            float hv = hcar;
            if (d == 0) {
#pragma unroll 4
                for (int g = 0; g < 16; ++g) {
                    const f32x4 a4 = *(const LAS f32x4*)(al + sth * 68 + 4 * g), b4 = *(const LAS f32x4*)(bl + sth * 68 + 4 * g); f32x4 o4;
                    hv = a4.x * hv + b4.x; o4.x = hv; hv = a4.y * hv + b4.y; o4.y = hv; hv = a4.z * hv + b4.z; o4.z = hv; hv = a4.w * hv + b4.w; o4.w = hv;
                    *(LAS f32x4*)(hl + sth * 68 + 4 * g) = o4;
                }
            } else {
#pragma unroll 4
                for (int g = 15; g >= 0; --g) {
                    const f32x4 a4 = *(const LAS f32x4*)(al + sth * 68 + 4 * g), b4 = *(const LAS f32x4*)(bl + sth * 68 + 4 * g); f32x4 o4;
                    hv = a4.w * hv + b4.w; o4.w = hv; hv = a4.z * hv + b4.z; o4.z = hv; hv = a4.y * hv + b4.y; o4.y = hv; hv = a4.x * hv + b4.x; o4.x = hv;
                    *(LAS f32x4*)(hl + sth * 68 + 4 * g) = o4;
                }
            }
            hcar = hv;
        }
        if (k + 1 < NCH) SC_CONV;
        asm volatile("s_waitcnt vmcnt(12)" ::: "memory");
        __syncthreads();
        {
#pragma unroll
            for (int r = 0; r < 3; ++r) {
                const int e = ht + 256 * r;
                if (e < 640) {
                    const int tt = otab[r] >> 8, dp = otab[r] & 255; const size_t row = (size_t)(rbA + t0A + tt);
                    const float h0 = hl[dp * 68 + tt], h1 = hl[(dp + 1) * 68 + tt];
                    unsigned* ap = (unsigned*)(ACT + row * 1280 + cq0 + dp);
                    if (first) *ap = pk2(h0, h1);
                    else {
                        const unsigned prev = early ? pvr[r] : __hip_atomic_load(ap, __ATOMIC_RELAXED, __HIP_MEMORY_SCOPE_AGENT);
                        const unsigned gg = early ? ggr[r] : *(const unsigned*)(XG + row * 2560 + cq0 + dp);
                        const float p0 = __builtin_bit_cast(float, prev << 16), p1 = __builtin_bit_cast(float, prev & 0xffff0000u);
                        const float g0 = __builtin_bit_cast(float, gg << 16), g1 = __builtin_bit_cast(float, gg & 0xffff0000u);
                        *ap = pk2((p0 + h0) * fgelu(g0), (p1 + h1) * fgelu(g1));
                    }
                }
            }
        }
        sA = sB; t0A = t0B; LsA = LsB; rbA = rbB; sB = sC; t0B = t0C; LsB = LsC; rbB = rbC;
    }
    __syncthreads();
#undef SC_PARAMS
#undef SC_PREFETCH
#undef SC_STAGE
#undef SC_CONV
}

constexpr int NPHASE = 30;
#ifndef ONLY_KIND
#define ONLY_KIND -1
#endif
#define EN(k) (ONLY_KIND < 0 || ONLY_KIND == (k))
#ifdef PROBE_SUB
#define PROBE_SUBV PROBE_SUB
#else
#define PROBE_SUBV 0
#endif
#ifndef MK_MULTI
#define MK_MULTI 0
#endif
__global__ void __launch_bounds__(NTHR, 2) mega_fwd(KArgs a_by_value) {
    extern __shared__ __attribute__((aligned(16))) unsigned char lds_raw[];
    LAS unsigned char* lds = (LAS unsigned char*)lds_raw;
    cg::grid_group grid = cg::this_grid();
    const int tid0 = threadIdx.x;
    if (tid0 < 2) ((LAS unsigned*)(lds + LDS_BARST))[tid0] = 0u;
    __syncthreads();
    (void)xcd_barrier_post((unsigned*)(a_by_value.ws + WS_BAR), (volatile LAS unsigned*)(lds + LDS_BARST));
    const int G = gridDim.x, bid0 = blockIdx.x, ngw = G * 8;
    const int ph_lo = a_by_value.ph_lo, ph_hi = a_by_value.ph_hi;
#pragma unroll 1
#ifdef PROBE_KIND
    for (int pp = 2 * ph_lo; pp < 2 * ph_hi; ++pp) {
        const int ph = pp >> 1;
#else
    for (int ph = ph_lo; ph < ph_hi; ++ph) {
#endif
        const KArgsP ap = opaque_kargs((KArgsP)__builtin_amdgcn_kernarg_segment_ptr());

        KArgsR a = *ap;
#define KOPQ int tid = tid0; asm volatile("" : "+v"(tid)); const int lane = tid & 63, wid = __builtin_amdgcn_readfirstlane(tid >> 6); int bid = bid0; asm volatile("" : "+s"(bid)); bid = __builtin_amdgcn_readfirstlane(bid); (void)lane; int gw = bid * 8 + wid; asm volatile("" : "+v"(gw)); gw = __builtin_amdgcn_readfirstlane(gw); (void)gw; int i = iL; asm volatile("" : "+s"(i)); i = __builtin_amdgcn_readfirstlane(i); const int j = i >> 1; const bool even = (i & 1) == 0; const int Mrows = (i == 3) ? ML : MT; (void)j; (void)even; (void)Mrows; const KArgsP apb_ = opaque_kargs(ap); KArgsR a = *apb_; unsigned char* ws = a.ws; bf16_t* ACT = (bf16_t*)(ws + WS_ACT); bf16_t* BIG = (bf16_t*)(ws + WS_BIG); bf16_t* WB = (bf16_t*)(ws + WS_WB); bf16_t* HCTX = (bf16_t*)(ws + WS_HCTX); float* MODS = (float*)(ws + WS_MODS); bf16_t* H = (bf16_t*)((unsigned char*)a.out + 64 * MiB); const float* mods_i = MODS + (size_t)i * 5 * 6144; const float* srcLat = (i == 0) ? a.in[0] : nullptr; const float* srcCtx = (i == 0) ? a.in[2] : nullptr; (void)ACT; (void)BIG; (void)WB; (void)HCTX; (void)mods_i; (void)srcLat; (void)srcCtx; (void)H;
        int kind, iL = 0, sub = 0;
        if (ph == 0) kind = 0;
        else if (ph == NPHASE - 1) kind = 9;
        else {
            const int q = ph - 1, st = q % 7; iL = q / 7;
            const bool ev = (iL & 1) == 0;
            kind = st == 0 ? 1 : st == 1 ? (ev ? 2 : 3) : st == 2 ? (ev ? 4 : 5) : st == 3 ? 7 : st == 4 ? 1 : st == 5 ? 3 : 7;
            sub = (st >= 4) ? 1 : 0;
        }
#ifdef PROBE_KIND
        if ((pp & 1) && kind != PROBE_KIND) continue;
#endif
        if (kind == 0 && EN(0)) { KOPQ
            p0_phase(a, lds, tid, lane, wid);
        } else if (kind == 1 && EN(1)) { KOPQ
            if (sub == 0) {
                norm_rows(srcLat, srcCtx, H, HCTX, a.in[6] + i * 1024, mods_i, 0, 1024, ACT, MT, gw, ngw, lane);
                if (even) { for (int it = bid; it < 512; it += G) khat_item(a, lds, j, it, tid); }
            } else {
                norm_rows(nullptr, nullptr, H, HCTX, a.in[7] + i * 1024, mods_i, 3072, 4096, ACT, Mrows, gw, ngw, lane);
            }
        } else if (kind == 2 && EN(2)) { KOPQ
            pg8::Gemm g{ACT, WB + WB_EVIN + (size_t)j * 3072 * 1024, MT, 3072, 1024}; pg8::StaticOrder S; S.init(MT, 3072, G, bid);
            EpiEvenIn E{(bf16_t*)(ws + WS_BIG + BIG_U), (bf16_t*)(ws + WS_BIG + BIG_Q), (bf16_t*)(ws + WS_BIG + BIG_K), (bf16_t*)(ws + WS_BIG + BIG_VT)};
            pg8::gemm_phase<EpiEvenIn, pg8::StaticOrder, true, true>(lds, g, S, E);
        } else if (kind == 3 && EN(3)) { KOPQ
            const int N = sub ? 4096 : 2560;
            const bf16_t* Bt = sub ? WB + WB_W1 + (size_t)i * 4096 * 1024 : WB + WB_ODIN + (size_t)j * 2560 * 1024;
            const int Mg = sub ? Mrows : MT;
            pg8::Gemm g{ACT, Bt, Mg, N, 1024}; pg8::StaticOrder S; S.init(Mg, N, G, bid);
            EpiStore E{BIG, N, sub};
            pg8::gemm_phase<EpiStore, pg8::StaticOrder, true, true>(lds, g, S, E);
        } else if (kind == 4 && EN(4)) { KOPQ
            const float s1 = wave_sum(a.in[24][j * 64 + lane] * a.in[25][j * 64 + lane], lane), s2 = wave_sum(a.in[26][j * 64 + lane] * a.in[27][j * 64 + lane], lane);
            const float lam_init = 0.8f - 0.6f * __expf(-0.3f * (float)i);
            const float lam = __expf(s1) - __expf(s2) + lam_init;
            const float* subg = a.in[28] + j * 128;
#ifdef PROBE_SUB
            const bool rep_ = (pp & 1);
#else
            const bool rep_ = false;
#endif
            if (!rep_ || PROBE_SUBV == 0)
            {
                const int vcu = (G % 8 == 0) ? (bid % 8) * (G / 8) + bid / 8 : bid;
                for (int it = vcu; it < 528; it += G) {
                    int b, hh, qrow0, ktlo;
                    if (it < 512) { b = it >> 7; hh = (it >> 5) & 3; qrow0 = b * 8192 + (it & 31) * 256; ktlo = 0; }
                    else { const int u = it - 512; b = u >> 2; hh = u & 3; qrow0 = ML + b * 256; ktlo = 128; }
                    attn_unit(a, lds, b, hh, qrow0, ktlo, 132, lam, 1.0f - lam_init, subg, tid);
                }
            }
            if (!rep_ || PROBE_SUBV == 1)
            for (int it = bid; it < 1024; it += G) hyena_lat_item(a, lds, j, it >> 1, it & 1, tid);
            if (!rep_ || PROBE_SUBV == 2)
            for (int it = bid; it < 512; it += G) hyena_ctx_item(a, lds, j, it, tid);
        } else if (kind == 5 && EN(5)) { KOPQ
            for (int cid = bid; cid < 256; cid += G) scan_chain(a, lds, j, cid, tid);
        } else if (kind == 7 && EN(7)) { KOPQ
            const int K = sub ? 4096 : (even ? 1024 : 1280);
            const bf16_t* A = sub ? BIG : ACT;
            const bf16_t* Bt = sub ? WB + WB_W2 + (size_t)i * 4096 * 1024 : (even ? WB + WB_EVOUT + (size_t)j * 1024 * 1024 : WB + WB_ODOUT + (size_t)j * 1024 * 1280);
            pg8::Gemm g{A, Bt, Mrows, 1024, K}; pg8::StaticOrder S; S.init(Mrows, 1024, G, bid);
            bf16_t* dstLat = (sub && i == 3) ? ACT : H;
            EpiResid E{sub ? nullptr : srcLat, sub ? nullptr : srcCtx, H, HCTX, dstLat, HCTX, mods_i, sub ? 5120 : 2048};
            pg8::gemm_phase<EpiResid, pg8::StaticOrder, true, true>(lds, g, S, E);
        } else { KOPQ
            final_norm(ACT, a.out, a.in[10], gw, ngw, lane);
        }
        #ifdef PROBE_SYNCS
        if (ph == 0) { for (int e = 0; e < PROBE_SYNCS; ++e) grid.sync(); }
#endif
#ifdef PROBE_KIND
        if (pp + 1 < 2 * ph_hi) grid.sync();
#else
        if (ph + 1 < ph_hi) { if (ph_hi > 4096) grid.sync(); else { XcdBarrier xb_; xb_.bar = (unsigned*)(ap->ws + WS_BAR); xb_.x = xb_xcc_id(); xb_.st = (volatile LAS unsigned*)(lds + LDS_BARST); xcd_barrier(xb_); } }
#endif
    }
}

extern "C" void kernel_launch(void* const* d_in, const int* in_sizes, int n_in, void* d_out, int out_size, void* d_ws, size_t ws_size, hipStream_t stream) {
    static int grid = 0;
    if (grid == 0) {
        if (n_in != 38 || in_sizes[0] != ML * DM || out_size != ML * DM || ws_size < WS_END) {
            fprintf(stderr, "kernel_launch: unexpected shapes: n_in %d in0 %d out %d ws %zu (need %zu)\n", n_in, n_in > 0 ? in_sizes[0] : -1, out_size, ws_size, (size_t)WS_END); grid = -1; return; }
        int dev = 0, cus = 0, per_cu = 0;
        (void)hipGetDevice(&dev); (void)hipDeviceGetAttribute(&cus, hipDeviceAttributeMultiprocessorCount, dev);
        if (hipFuncSetAttribute((const void*)mega_fwd, hipFuncAttributeMaxDynamicSharedMemorySize, LDS_BYTES) != hipSuccess) { fprintf(stderr, "kernel_launch: hipFuncSetAttribute failed\n"); grid = -1; return; }
        if (hipOccupancyMaxActiveBlocksPerMultiprocessor(&per_cu, (const void*)mega_fwd, NTHR, LDS_BYTES) != hipSuccess || per_cu < 1) { fprintf(stderr, "kernel_launch: occupancy query says %d\n", per_cu); per_cu = 1; }
        (void)hipGetLastError();
        grid = cus * 1;
        if (grid <= 0) grid = 256;
    }
    if (grid < 0) return;
    if (hipMemsetAsync((char*)d_ws + WS_BAR, 0, 16384, stream) != hipSuccess) { fprintf(stderr, "kernel_launch: memset of the barrier words failed\n"); return; }
    KArgs a{};
    for (int k = 0; k < 38; ++k) a.in[k] = (const float*)d_in[k];
    a.out = (float*)d_out; a.ws = (unsigned char*)d_ws;
#if MK_MULTI
    for (int p = 0; p < NPHASE; ++p) { a.ph_lo = p; a.ph_hi = p + 1; hipLaunchKernelGGL(mega_fwd, dim3(grid), dim3(NTHR), LDS_BYTES, stream, a); }
#else
    a.ph_lo = 0; a.ph_hi = NPHASE;
    void* args[] = {&a};
    hipError_t e = hipLaunchCooperativeKernel((const void*)mega_fwd, dim3(grid), dim3(NTHR), args, LDS_BYTES, stream);
    if (e != hipSuccess) fprintf(stderr, "kernel_launch: cooperative launch failed: %s (grid %d)\n", hipGetErrorString(e), grid);
#endif
}
```

```cpp
#include <hip/hip_runtime.h>
#include <hip/hip_cooperative_groups.h>
#include <cstdio>
#include <cstdint>
namespace cg = cooperative_groups;
namespace pg8 {
#define PG8_LAS __attribute__((address_space(3)))
typedef unsigned short bf16_t;
typedef short bf16x8 __attribute__((ext_vector_type(8)));
typedef float f32x4 __attribute__((ext_vector_type(4)));
typedef unsigned u32x4 __attribute__((ext_vector_type(4)));
constexpr int BM = 256, BK = 64, HALF = 128, HTB = HALF * BK * 2  , STAGE_BYTES = 8 * HTB, NXCD = 8, WGM = 8;

__host__ __device__ __forceinline__ int lds_byte(int r, int c) { const int st = (r >> 4) * 2 + (c >> 5), rr = r & 15, cc = c & 31, ob = rr * 64 + cc * 2; return st * 1024 + (ob ^ (((ob >> 9) & 1) << 5)); }
__host__ __device__ __forceinline__ void stage_rc(int b, int& R, int& C) { const int st = b / 1024, sb = b % 1024, swz = sb ^ (((sb >> 9) & 1) << 5); R = (st >> 1) * 16 + swz / 64; C = (st & 1) * 32 + (swz % 64) / 2; }
__host__ __device__ __forceinline__ int perm32(int rho) { const int n = rho >> 4, i = rho & 15; return 8 * (i >> 2) + 4 * n + (i & 3); }

struct Unit { int pm, pn; };
struct Gemm { const bf16_t* A; const bf16_t* Bt; int M, N, K; };

struct StaticOrder {
    int nM, nN, nwg, G, c;
    __host__ __device__ void init(int M, int N, int G_, int c_) { nM = M / BM; nN = N / BM; nwg = nM * nN; G = G_; c = c_; }
    __host__ __device__ bool next(int i, Unit& u) const {
        const long L = (long)i * G + c; if (L >= nwg) return false;
        int wgid = (int)L; { const int q = nwg / NXCD, r = nwg % NXCD, xcd = wgid % NXCD, off = wgid / NXCD; wgid = (xcd < r ? xcd * (q + 1) : r * (q + 1) + (xcd - r) * q) + off; }
        const int nig = WGM * nN, gid = wgid / nig, fm = gid * WGM, gsz = (nM - fm) < WGM ? (nM - fm) : WGM;
        u.pm = fm + ((wgid % nig) % gsz); u.pn = (wgid % nig) / gsz; return true;
    }
    __device__ __forceinline__ void a_ready(const Unit&) const {}
    __device__ __forceinline__ void done(const Unit&) const {}
};

__device__ __forceinline__ unsigned cvt_pk_bf16(float lo, float hi) { unsigned r; asm volatile("v_cvt_pk_bf16_f32 %0, %1, %2" : "=v"(r) : "v"(lo), "v"(hi)); return r; }
template <class Epi, class Sched, bool ALIGN_EPI = false, bool SP2 = false>
__device__ __forceinline__ void gemm_phase(PG8_LAS unsigned char* lds, const Gemm g, const Sched& S, const Epi& E) {
    int tid_op = threadIdx.x; asm volatile("" : "+v"(tid_op));
    const int tid = tid_op, wid = __builtin_amdgcn_readfirstlane(tid >> 6), lane = tid & 63, wr = wid >> 2, wc = wid & 3, fr = lane & 15, fq = lane >> 4;
    const int K = g.K, nt = K / BK;
    unsigned voffA[2], voffB[2];
#pragma unroll
    for (int i = 0; i < 2; ++i) { int R, C; stage_rc(tid * 16 + i * 8192, R, C); const int Rb = Epi::PERM ? ((R & ~31) + perm32(R & 31)) : R;
        voffA[i] = (unsigned)(R * K + C) * 2u; voffB[i] = (unsigned)(Rb * K + C) * 2u; }
    const size_t kstep = (size_t)(BK * 2);
    const size_t hstep = (size_t)HALF * K * 2;
    const size_t tstep = 2 * hstep;
    const unsigned ldsw = (unsigned)wid * 1024u;
    const int aoff = lds_byte(wr * 64 + fr, fq * 8), boff = lds_byte(wc * 32 + fr, fq * 8);
#define PG8_SA(b, h) (((b) * 2 + (h)) * HTB)
#define PG8_SB(b, h) ((4 + (b) * 2 + (h)) * HTB)
#define PG8_STAGE(bufoff, gbase, voff) do { _Pragma("unroll") for (int _i = 0; _i < 2; ++_i) \
        __builtin_amdgcn_global_load_lds((const unsigned*)((const char*)(gbase) + (voff)[_i]), (PG8_LAS unsigned*)(lds + (bufoff) + ldsw + _i * 8192), 16, 0, 0); } while (0)
#define PG8_LDA(dst, b, h) do { _Pragma("unroll") for (int m = 0; m < 4; ++m) _Pragma("unroll") for (int k = 0; k < 2; ++k) dst[m][k] = *(const PG8_LAS bf16x8*)(lds + PG8_SA(b, h) + aoff + m * 2048 + k * 1024); } while (0)
#define PG8_LDB(dst, b, h) do { _Pragma("unroll") for (int n = 0; n < 2; ++n) _Pragma("unroll") for (int k = 0; k < 2; ++k) dst[n][k] = *(const PG8_LAS bf16x8*)(lds + PG8_SB(b, h) + boff + n * 2048 + k * 1024); } while (0)
#define PG8_MMA(ai, bj, At, Bt) do { __builtin_amdgcn_s_setprio(1); _Pragma("unroll") for (int m = 0; m < 4; ++m) _Pragma("unroll") for (int n = 0; n < 2; ++n) _Pragma("unroll") for (int k = 0; k < 2; ++k) \
        acc[ai][bj][m][n] = __builtin_amdgcn_mfma_f32_16x16x32_bf16(Bt[n][k], At[m][k], acc[ai][bj][m][n], 0, 0, 0); __builtin_amdgcn_s_setprio(0); } while (0)
#define PG8_WAIT_V(n) asm volatile("s_waitcnt vmcnt(" #n ")" ::: "memory")
#define PG8_WAIT_L(n) asm volatile("s_waitcnt lgkmcnt(" #n ")" ::: "memory")
#define PG8_BAR __builtin_amdgcn_s_barrier()
#define PG8_SCHED __builtin_amdgcn_sched_barrier(0)
    Unit cur, nxt; int ui = 0;
    if (!S.next(0, cur)) return;
    f32x4 acc[2][2][4][2];
#pragma unroll
    for (int a = 0; a < 2; ++a)
#pragma unroll
        for (int b = 0; b < 2; ++b)
#pragma unroll
            for (int m = 0; m < 4; ++m)
#pragma unroll
                for (int n = 0; n < 2; ++n) acc[a][b][m][n] = (f32x4){0.f, 0.f, 0.f, 0.f};
    bf16x8 At[4][2], B0[2][2], B1[2][2];
    const char* cA = (const char*)g.A + (size_t)cur.pm * tstep; const char* cB = (const char*)g.Bt + (size_t)cur.pn * tstep;
    S.a_ready(cur);
    if constexpr (SP2) {
        PG8_STAGE(PG8_SB(0, 0), cB, voffB); PG8_STAGE(PG8_SB(0, 1), cB + hstep, voffB); PG8_STAGE(PG8_SA(0, 0), cA, voffA); PG8_STAGE(PG8_SA(0, 1), cA + hstep, voffA);
        if (wr == 1) PG8_BAR;
        PG8_WAIT_V(2); PG8_BAR;
        PG8_STAGE(PG8_SB(1, 0), cB + kstep, voffB); PG8_STAGE(PG8_SA(1, 0), cA + kstep, voffA); PG8_STAGE(PG8_SB(1, 1), cB + hstep + kstep, voffB);
        PG8_WAIT_V(6); PG8_BAR;
    } else {
        PG8_STAGE(PG8_SB(0, 0), cB, voffB); PG8_STAGE(PG8_SA(0, 0), cA, voffA); PG8_STAGE(PG8_SB(0, 1), cB + hstep, voffB); PG8_STAGE(PG8_SA(0, 1), cA + hstep, voffA);
        if (wr == 1) PG8_BAR;
        PG8_WAIT_V(4); PG8_BAR;
        PG8_STAGE(PG8_SB(1, 0), cB + kstep, voffB); PG8_STAGE(PG8_SA(1, 0), cA + kstep, voffA); PG8_STAGE(PG8_SB(1, 1), cB + hstep + kstep, voffB);
        PG8_WAIT_V(6); PG8_BAR;
    }
    for (;;) {
        const bool has_next = S.next(ui + 1, nxt);
        const char* nA = has_next ? (const char*)g.A + (size_t)nxt.pm * tstep : cA; const char* nB = has_next ? (const char*)g.Bt + (size_t)nxt.pn * tstep : cB;
        for (int t = 0; t < nt; t += 2) {
            const bool last = (t == nt - 2);
            const char* a1 = cA + (size_t)(t + 1) * kstep;
            const char* a2 = last ? nA : cA + (size_t)(t + 2) * kstep; const char* b2 = last ? nB : cB + (size_t)(t + 2) * kstep;
            const char* a3 = a2 + kstep; const char* b3 = b2 + kstep;
            if (last && has_next) S.a_ready(nxt);
            if constexpr (SP2) {
            PG8_LDB(B0, 0, 0); PG8_LDB(B1, 0, 1); PG8_SCHED; PG8_LDA(At, 0, 0); PG8_STAGE(PG8_SA(1, 1), a1 + hstep, voffA);
            PG8_WAIT_V(8); PG8_WAIT_L(0); PG8_BAR; PG8_MMA(0, 0, At, B0); PG8_MMA(0, 1, At, B1); PG8_BAR; PG8_SCHED;
            PG8_LDA(At, 0, 1); PG8_STAGE(PG8_SB(0, 0), b2, voffB); PG8_STAGE(PG8_SB(0, 1), b2 + hstep, voffB); PG8_STAGE(PG8_SA(0, 0), a2, voffA);
            PG8_WAIT_V(8); PG8_WAIT_L(0); PG8_BAR; PG8_MMA(1, 0, At, B0); PG8_MMA(1, 1, At, B1); PG8_BAR; PG8_SCHED;
            PG8_LDB(B0, 1, 0); PG8_LDB(B1, 1, 1); PG8_SCHED; PG8_LDA(At, 1, 0); PG8_STAGE(PG8_SA(0, 1), a2 + hstep, voffA);
            PG8_WAIT_V(8); PG8_WAIT_L(0); PG8_BAR; PG8_MMA(0, 0, At, B0); PG8_MMA(0, 1, At, B1); PG8_BAR; PG8_SCHED;
            PG8_LDA(At, 1, 1); PG8_STAGE(PG8_SB(1, 0), b3, voffB); PG8_STAGE(PG8_SB(1, 1), b3 + hstep, voffB); PG8_STAGE(PG8_SA(1, 0), a3, voffA);
            PG8_WAIT_V(8); PG8_WAIT_L(0); PG8_BAR; PG8_MMA(1, 0, At, B0); PG8_MMA(1, 1, At, B1); PG8_BAR; PG8_SCHED;
            } else {
            PG8_LDB(B0, 0, 0); PG8_SCHED; PG8_LDA(At, 0, 0); PG8_STAGE(PG8_SA(1, 1), a1 + hstep, voffA);
            PG8_WAIT_L(8); PG8_BAR; PG8_WAIT_L(0); PG8_MMA(0, 0, At, B0); PG8_BAR; PG8_SCHED;
            PG8_LDB(B1, 0, 1); PG8_STAGE(PG8_SB(0, 0), b2, voffB);
            PG8_BAR; PG8_WAIT_L(0); PG8_MMA(0, 1, At, B1); PG8_BAR;
            PG8_LDA(At, 0, 1); PG8_STAGE(PG8_SA(0, 0), a2, voffA);
            PG8_BAR; PG8_WAIT_L(0); PG8_MMA(1, 0, At, B0); PG8_BAR; PG8_SCHED;
            PG8_STAGE(PG8_SB(0, 1), b2 + hstep, voffB);
            PG8_WAIT_V(6); PG8_BAR; PG8_MMA(1, 1, At, B1); PG8_BAR;
            PG8_LDB(B0, 1, 0); PG8_SCHED; PG8_LDA(At, 1, 0); PG8_STAGE(PG8_SA(0, 1), a2 + hstep, voffA);
            PG8_WAIT_L(8); PG8_BAR; PG8_WAIT_L(0); PG8_MMA(0, 0, At, B0); PG8_BAR; PG8_SCHED;
            PG8_LDB(B1, 1, 1); PG8_STAGE(PG8_SB(1, 0), b3, voffB);
            PG8_BAR; PG8_WAIT_L(0); PG8_MMA(0, 1, At, B1); PG8_BAR;
            PG8_LDA(At, 1, 1); PG8_STAGE(PG8_SA(1, 0), a3, voffA);
            PG8_BAR; PG8_WAIT_L(0); PG8_MMA(1, 0, At, B0); PG8_BAR; PG8_SCHED;
            PG8_STAGE(PG8_SB(1, 1), b3 + hstep, voffB);
            PG8_WAIT_V(6); PG8_BAR; PG8_MMA(1, 1, At, B1); PG8_BAR;
            }
        }
        if constexpr (ALIGN_EPI) { if (wr == 0) PG8_BAR; }
        if constexpr (!Epi::AFTER_DRAIN) { E(acc, cur, wr, wc, fr, fq); S.done(cur); }
        if (!has_next) break;
#pragma unroll
        for (int a = 0; a < 2; ++a)
#pragma unroll
            for (int b = 0; b < 2; ++b)
#pragma unroll
                for (int m = 0; m < 4; ++m)
#pragma unroll
                    for (int n = 0; n < 2; ++n) acc[a][b][m][n] = (f32x4){0.f, 0.f, 0.f, 0.f};
        cur = nxt; cA = nA; cB = nB; ++ui;
        if constexpr (ALIGN_EPI) { if (wr == 1) PG8_BAR; }
    }
    PG8_WAIT_V(0);
    if constexpr (!ALIGN_EPI) { if (wr == 0) PG8_BAR; }
    PG8_BAR;
    if constexpr (Epi::AFTER_DRAIN) { E.fused(acc, cur, wr, wc, fr, fq, lds, wid, lane); S.done(cur); }
#undef PG8_SA
#undef PG8_SB
#undef PG8_STAGE
#undef PG8_LDA
#undef PG8_LDB
#undef PG8_MMA
#undef PG8_WAIT_V
#undef PG8_WAIT_L
#undef PG8_BAR
#undef PG8_SCHED
}
}

#define LAS __attribute__((address_space(3)))
typedef unsigned short bf16_t;
typedef short bf16x8 __attribute__((ext_vector_type(8)));
typedef float f32x4 __attribute__((ext_vector_type(4)));
typedef float f32x16 __attribute__((ext_vector_type(16)));
typedef unsigned u32x4 __attribute__((ext_vector_type(4)));
typedef unsigned u32x2 __attribute__((ext_vector_type(2)));
typedef _Float16 h16x2 __attribute__((ext_vector_type(2)));
typedef float cf2 __attribute__((ext_vector_type(2)));
__device__ __forceinline__ cf2 MKCF(float x, float y) { cf2 r; r.x = x; r.y = y; return r; }

constexpr int NB = 4, SEQ = 8192, DM = 1024, LC = 256;
constexpr int ML = NB * SEQ, MC = NB * LC, MT = ML + MC;
constexpr int NKEY = SEQ + LC;
constexpr int NTHR = 512;
constexpr int LDS_BYTES = 147456, LDS_BARST = 147200;
constexpr size_t MiB = 1u << 20;
constexpr size_t WS_BIG = 0, WS_ACT = 264 * MiB, WS_HCTX = 347 * MiB, WS_WB = 351 * MiB, WS_MODS = 446 * MiB, WS_H2 = 447 * MiB, WS_WSC = 452 * MiB, WS_BAR = 455 * MiB, WS_END = 456 * MiB;
constexpr size_t BIG_U = 0, BIG_Q = 99 * MiB, BIG_K = 132 * MiB, BIG_VT = 165 * MiB, BIG_KH = 198 * MiB;
constexpr size_t WB_W1 = 0, WB_W2 = WB_W1 + 4ull * 4096 * 1024, WB_EVIN = WB_W2 + 4ull * 4096 * 1024, WB_EVOUT = WB_EVIN + 2ull * 3072 * 1024,
                 WB_ODIN = WB_EVOUT + 2ull * 1024 * 1024, WB_ODOUT = WB_ODIN + 2ull * 2560 * 1024, WB_ENDE = WB_ODOUT + 2ull * 1024 * 1280;
static_assert(WB_ENDE * 2 <= 95 * MiB, "weights");
constexpr int NCH = 132;

__device__ __forceinline__ unsigned f2bf(float f) { unsigned u = __builtin_bit_cast(unsigned, f); return (u + 0x7fffu + ((u >> 16) & 1u)) >> 16; }
__device__ __forceinline__ unsigned pk2(float lo, float hi) { unsigned r; asm("v_cvt_pk_bf16_f32 %0, %1, %2" : "=v"(r) : "v"(lo), "v"(hi)); return r; }
__device__ __forceinline__ float bf2f(bf16_t h) { return __builtin_bit_cast(float, (unsigned)h << 16); }
__device__ __forceinline__ float shflx(float v, int m, int lane) { return __builtin_bit_cast(float, __builtin_amdgcn_ds_bpermute((lane ^ m) << 2, __builtin_bit_cast(int, v))); }
__device__ __forceinline__ float wave_sum(float v, int lane) {
#pragma unroll
    for (int o = 1; o < 64; o <<= 1) v += shflx(v, o, lane);
    return v;
}
__device__ __forceinline__ float sin_rev(float r) { return __builtin_amdgcn_sinf(r); }
__device__ __forceinline__ float cos_rev(float r) { return __builtin_amdgcn_cosf(r); }
__device__ __forceinline__ float fsin(float x) { float r = x * 0.15915494309189535f; r = r - floorf(r); return __builtin_amdgcn_sinf(r); }
__device__ __forceinline__ float fcos(float x) { float r = x * 0.15915494309189535f; r = r - floorf(r); return __builtin_amdgcn_cosf(r); }
__device__ __forceinline__ float sigmoidf_(float x) { return 1.0f / (1.0f + __expf(-x)); }
__device__ __forceinline__ float gelu_tanh(float g) { const float u = 0.7978845608028654f * (g + 0.044715f * g * g * g); const float t = 1.0f - 2.0f / (1.0f + __expf(2.0f * u)); return 0.5f * g * (1.0f + t); }

struct EpiStore {
    static constexpr bool PERM = true, AFTER_DRAIN = false;
    bf16_t* O; int ldc; int act;
    __device__ __forceinline__ void operator()(const f32x4 (&acc)[2][2][4][2], const pg8::Unit& u, int wr, int wc, int fr_, int fq_) const {
        int fr = fr_, fq = fq_; asm volatile("" : "+v"(fr), "+v"(fq));
        const int row0 = u.pm * 256 + wr * 64 + fr, col0 = u.pn * 256 + wc * 32 + 8 * fq;
#pragma unroll
        for (int ai = 0; ai < 2; ++ai)
#pragma unroll
            for (int m = 0; m < 4; ++m) {
                bf16_t* rowp = O + (size_t)(row0 + ai * 128 + m * 16) * ldc + col0;
#pragma unroll
                for (int bj = 0; bj < 2; ++bj) {
                    f32x4 v0 = acc[ai][bj][m][0], v1 = acc[ai][bj][m][1];
                    if (act) {
#pragma unroll
                        for (int x = 0; x < 4; ++x) { float a = fmaxf(v0[x], 0.f), b = fmaxf(v1[x], 0.f); v0[x] = a * a; v1[x] = b * b; }
                    }
                    u32x4 w; w.x = pk2(v0[0], v0[1]); w.y = pk2(v0[2], v0[3]); w.z = pk2(v1[0], v1[1]); w.w = pk2(v1[2], v1[3]);
                    *(u32x4*)(rowp + bj * 128) = w;
                }
            }
    }
};

struct EpiResid {
    static constexpr bool PERM = true, AFTER_DRAIN = false;
    const float* srcLat; const float* srcCtx; bf16_t* HLat; bf16_t* HCtx; const float* mods; int gateOff;
    __device__ __forceinline__ void operator()(const f32x4 (&acc)[2][2][4][2], const pg8::Unit& u, int wr, int wc, int fr_, int fq_) const {
        int fr = fr_, fq = fq_; asm volatile("" : "+v"(fr), "+v"(fq));
        const int row0 = u.pm * 256 + wr * 64 + fr, col0 = u.pn * 256 + wc * 32 + 8 * fq;
        const int rowt = u.pm * 256;
        const float* gp = mods + (rowt < ML ? (rowt >> 13) : 4) * 6144 + gateOff + col0;
        f32x4 g[2][2];
#pragma unroll
        for (int bj = 0; bj < 2; ++bj) { g[bj][0] = *(const f32x4*)(gp + bj * 128); g[bj][1] = *(const f32x4*)(gp + bj * 128 + 4); }
        const bool f32src = srcLat != nullptr;
#pragma unroll
        for (int ai = 0; ai < 2; ++ai)
#pragma unroll
            for (int m = 0; m < 4; ++m) {
                const int row = row0 + ai * 128 + m * 16;
                const size_t off = (row < ML) ? (size_t)row * 1024 + col0 : (size_t)(row - ML) * 1024 + col0;
                bf16_t* dp = ((row < ML) ? HLat : HCtx) + off;
#pragma unroll
                for (int bj = 0; bj < 2; ++bj) {
                    f32x4 s0, s1;
                    if (f32src) { const float* sp = ((row < ML) ? srcLat : srcCtx) + off + bj * 128; s0 = *(const f32x4*)sp; s1 = *(const f32x4*)(sp + 4); }
                    else { const u32x4 w = *(const u32x4*)(dp + bj * 128);
                        s0.x = __builtin_bit_cast(float, w.x << 16); s0.y = __builtin_bit_cast(float, w.x & 0xffff0000u); s0.z = __builtin_bit_cast(float, w.y << 16); s0.w = __builtin_bit_cast(float, w.y & 0xffff0000u);
                        s1.x = __builtin_bit_cast(float, w.z << 16); s1.y = __builtin_bit_cast(float, w.z & 0xffff0000u); s1.z = __builtin_bit_cast(float, w.w << 16); s1.w = __builtin_bit_cast(float, w.w & 0xffff0000u); }
                    const f32x4 o0 = s0 + g[bj][0] * acc[ai][bj][m][0], o1 = s1 + g[bj][1] * acc[ai][bj][m][1];
                    u32x4 ow; ow.x = pk2(o0.x, o0.y); ow.y = pk2(o0.z, o0.w); ow.z = pk2(o1.x, o1.y); ow.w = pk2(o1.z, o1.w);
                    *(u32x4*)(dp + bj * 128) = ow;
                }
            }
    }
};

struct EpiEvenIn {
    static constexpr bool PERM = true, AFTER_DRAIN = false;
    bf16_t *U, *Q, *K, *VT;
    __device__ __forceinline__ void operator()(const f32x4 (&acc)[2][2][4][2], const pg8::Unit& u, int wr, int wc, int fr_, int fq_) const {
        int fr = fr_, fq = fq_; asm volatile("" : "+v"(fr), "+v"(fq));
        const int row0 = u.pm * 256 + wr * 64 + fr;
        const int pn = u.pn;
        if (pn < 6) {
            const int col0 = pn * 256 + wc * 32 + 8 * fq;
#pragma unroll
            for (int ai = 0; ai < 2; ++ai)
#pragma unroll
                for (int m = 0; m < 4; ++m) {
                    const int row = row0 + ai * 128 + m * 16;
                    bf16_t* base; size_t cs;
                    if (row < ML) { base = U + (size_t)(row >> 13) * 1536 * 8192 + (row & 8191); cs = 8192; }
                    else { const int rr = row - ML; base = U + (size_t)4 * 1536 * 8192 + (size_t)(rr >> 8) * 1536 * 256 + (rr & 255); cs = 256; }
#pragma unroll
                    for (int bj = 0; bj < 2; ++bj) {
                        bf16_t* cpn = base + (size_t)(col0 + bj * 128) * cs;
                        const f32x4 v0 = acc[ai][bj][m][0], v1 = acc[ai][bj][m][1];
                        const unsigned w0 = pk2(v0[0], v0[1]), w1 = pk2(v0[2], v0[3]), w2 = pk2(v1[0], v1[1]), w3 = pk2(v1[2], v1[3]);
                        cpn[0] = (bf16_t)w0; cpn[cs] = (bf16_t)(w0 >> 16); cpn[2 * cs] = (bf16_t)w1; cpn[3 * cs] = (bf16_t)(w1 >> 16);
                        cpn[4 * cs] = (bf16_t)w2; cpn[5 * cs] = (bf16_t)(w2 >> 16); cpn[6 * cs] = (bf16_t)w3; cpn[7 * cs] = (bf16_t)(w3 >> 16);
                    }
                }
        } else if (pn < 10) {
            const bool isq = pn < 8;
            bf16_t* O = isq ? Q : K;
            const int col0 = ((pn - 6) & 1) * 256 + wc * 32 + 8 * fq;
            const float osc = isq ? 0.18033688011112042f : 1.0f;
            const bool lat = (u.pm * 256) < ML;
            const float fbase = -(float)(8 * (fq & 1)) * 0.8304820237218406f;
            const float sgn = (fq < 2) ? -1.0f : 1.0f;
#pragma unroll
            for (int ai = 0; ai < 2; ++ai)
#pragma unroll
                for (int m = 0; m < 4; ++m) {
                    const int row = row0 + ai * 128 + m * 16;
                    const int t = row & 8191;
                    const float pos = (float)((wc & 1) ? (t & 63) : (t >> 6));
                    bf16_t* rowp = O + (size_t)row * 512 + col0;
                    float o0[8], o1[8];
#pragma unroll
                    for (int e = 0; e < 8; ++e) {
                        float rv = pos * (__builtin_amdgcn_exp2f(fbase - (float)e * 0.8304820237218406f) * 0.15915494309189535f); rv = rv - floorf(rv);
                        const float cs = lat ? cos_rev(rv) : 1.0f, sn = (lat ? sin_rev(rv) : 0.0f) * sgn;
                        const float va = acc[ai][0][m][e >> 2][e & 3], vb = acc[ai][1][m][e >> 2][e & 3];
                        const float pa = shflx(va, 32, fq * 16 + fr), pb = shflx(vb, 32, fq * 16 + fr);
                        o0[e] = (va * cs + pa * sn) * osc; o1[e] = (vb * cs + pb * sn) * osc;
                    }
                    { u32x4 w; w.x = pk2(o0[0], o0[1]); w.y = pk2(o0[2], o0[3]); w.z = pk2(o0[4], o0[5]); w.w = pk2(o0[6], o0[7]); *(u32x4*)(rowp) = w; }
                    { u32x4 w; w.x = pk2(o1[0], o1[1]); w.y = pk2(o1[2], o1[3]); w.z = pk2(o1[4], o1[5]); w.w = pk2(o1[6], o1[7]); *(u32x4*)(rowp + 128) = w; }
                }
        } else {
#pragma unroll
            for (int ai = 0; ai < 2; ++ai)
#pragma unroll
                for (int m = 0; m < 4; ++m) {
                    const int row = row0 + ai * 128 + m * 16;
                    int b, key;
                    if (row < ML) { b = row >> 13; key = row & 8191; } else { const int rr = row - ML; b = rr >> 8; key = 8192 + (rr & 255); }
#pragma unroll
                    for (int bj = 0; bj < 2; ++bj) {
                        const int hh = (pn - 10) * 2 + bj;
                        bf16_t* vp = VT + ((size_t)(b * 4 + hh) * 128 + wc * 32 + 8 * fq) * NKEY + key;
#pragma unroll
                        for (int x = 0; x < 4; ++x) { vp[(size_t)x * NKEY] = (bf16_t)f2bf(acc[ai][bj][m][0][x]); vp[(size_t)(4 + x) * NKEY] = (bf16_t)f2bf(acc[ai][bj][m][1][x]); }
                    }
                }
        }
    }
};

__device__ __forceinline__ void load_row16(const float* f32p, const bf16_t* b16p, int lane, float (&v)[16]) {
    if (f32p) {
#pragma unroll
        for (int j = 0; j < 2; ++j) { const f32x4 a0 = *(const f32x4*)(f32p + 8 * lane + 512 * j), a1 = *(const f32x4*)(f32p + 8 * lane + 512 * j + 4);
            v[8 * j] = a0.x; v[8 * j + 1] = a0.y; v[8 * j + 2] = a0.z; v[8 * j + 3] = a0.w; v[8 * j + 4] = a1.x; v[8 * j + 5] = a1.y; v[8 * j + 6] = a1.z; v[8 * j + 7] = a1.w; }
    } else {
#pragma unroll
        for (int j = 0; j < 2; ++j) { const u32x4 w = *(const u32x4*)(b16p + 8 * lane + 512 * j);
            v[8 * j] = __builtin_bit_cast(float, w.x << 16); v[8 * j + 1] = __builtin_bit_cast(float, w.x & 0xffff0000u); v[8 * j + 2] = __builtin_bit_cast(float, w.y << 16); v[8 * j + 3] = __builtin_bit_cast(float, w.y & 0xffff0000u);
            v[8 * j + 4] = __builtin_bit_cast(float, w.z << 16); v[8 * j + 5] = __builtin_bit_cast(float, w.z & 0xffff0000u); v[8 * j + 6] = __builtin_bit_cast(float, w.w << 16); v[8 * j + 7] = __builtin_bit_cast(float, w.w & 0xffff0000u); }
    }
}
__device__ __forceinline__ void norm_rows(const float* srcLat, const float* srcCtx, const bf16_t* HLat, const bf16_t* HCtx, const float* g, const float* mods, int shOff, int scOff, bf16_t* A, int nrows, int gw, int ngw, int lane) {
    for (int row = gw; row < nrows; row += ngw) {
        const float* md = mods + (row < ML ? (row >> 13) : 4) * 6144;
        const size_t off = (row < ML) ? (size_t)row * 1024 : (size_t)(row - ML) * 1024;
        float v[16];
        load_row16(srcLat ? ((row < ML) ? srcLat : srcCtx) + off : nullptr, ((row < ML) ? HLat : HCtx) + off, lane, v);
        float ss = 0.f;
#pragma unroll
        for (int e = 0; e < 16; ++e) ss += v[e] * v[e];
        ss = wave_sum(ss, lane);
        const float rstd = rsqrtf(ss * (1.0f / 1024.0f) + 1e-6f);
#pragma unroll
        for (int j = 0; j < 2; ++j) {
            const int k = 8 * lane + 512 * j;
            float y[8];
#pragma unroll
            for (int hq = 0; hq < 2; ++hq) {
                const f32x4 gg = *(const f32x4*)(g + k + 4 * hq), sc = *(const f32x4*)(md + scOff + k + 4 * hq), sh = *(const f32x4*)(md + shOff + k + 4 * hq);
                y[4 * hq] = v[8 * j + 4 * hq] * rstd * gg.x * (sc.x + 1.0f) + sh.x; y[4 * hq + 1] = v[8 * j + 4 * hq + 1] * rstd * gg.y * (sc.y + 1.0f) + sh.y;
                y[4 * hq + 2] = v[8 * j + 4 * hq + 2] * rstd * gg.z * (sc.z + 1.0f) + sh.z; y[4 * hq + 3] = v[8 * j + 4 * hq + 3] * rstd * gg.w * (sc.w + 1.0f) + sh.w;
            }
            u32x4 w; w.x = pk2(y[0], y[1]); w.y = pk2(y[2], y[3]); w.z = pk2(y[4], y[5]); w.w = pk2(y[6], y[7]);
            *(u32x4*)(A + (size_t)row * 1024 + k) = w;
        }
    }
}
__device__ __forceinline__ void final_norm(const bf16_t* H16, float* out, float* tmp, const float* g, int gw, int ngw, int lane) {
    for (int row = gw; row < ML; row += ngw) {
        float v[16];
        load_row16(nullptr, H16 + (size_t)row * 1024, lane, v);
        float ss = 0.f;
#pragma unroll
        for (int e = 0; e < 16; ++e) ss += v[e] * v[e];
        ss = wave_sum(ss, lane);
        const float rstd = rsqrtf(ss * (1.0f / 1024.0f) + 1e-6f);
        float* dst = (row < 16384) ? out + (size_t)row * 1024 : tmp + (size_t)(row - 16384) * 1024;
#pragma unroll
        for (int j = 0; j < 2; ++j)
#pragma unroll
            for (int hq = 0; hq < 2; ++hq) {
                const int k = 8 * lane + 512 * j + 4 * hq; const f32x4 gg = *(const f32x4*)(g + k);
                f32x4 y; y.x = v[8 * j + 4 * hq] * rstd * gg.x; y.y = v[8 * j + 4 * hq + 1] * rstd * gg.y; y.z = v[8 * j + 4 * hq + 2] * rstd * gg.z; y.w = v[8 * j + 4 * hq + 3] * rstd * gg.w;
                *(f32x4*)(dst + k) = y;
            }
    }
}
__device__ __forceinline__ void final_copy(const float* tmp, float* out_hi, int gtid, int nthr) {
    const f32x4* s = (const f32x4*)tmp; f32x4* d = (f32x4*)out_hi;
    for (int i = gtid; i < 16384 * 256; i += nthr) d[i] = s[i];
}

__device__ __forceinline__ void transpose_item(const float* W, int K, int N, bf16_t* WT, LAS float* scr, int item, int lane) {
    const int nblk = N / 32, kb = item / nblk, nb = item % nblk, k0 = 64 * kb, n0 = 32 * nb;
#pragma unroll 8
    for (int i = 0; i < 32; ++i) { const int kk = 2 * i + (lane >> 5); scr[kk * 33 + (lane & 31)] = W[(size_t)(k0 + kk) * N + n0 + (lane & 31)]; }
    asm volatile("s_waitcnt lgkmcnt(0)" ::: "memory");
    const int c = lane & 7;
#pragma unroll
    for (int j = 0; j < 4; ++j) {
        const int n = (lane >> 3) + 8 * j; const LAS float* s = scr + (8 * c) * 33 + n;
        u32x4 o; o.x = pk2(s[0 * 33], s[1 * 33]); o.y = pk2(s[2 * 33], s[3 * 33]); o.z = pk2(s[4 * 33], s[5 * 33]); o.w = pk2(s[6 * 33], s[7 * 33]);
        *(u32x4*)(WT + (size_t)(n0 + n) * K + k0 + 8 * c) = o;
    }
    asm volatile("s_waitcnt lgkmcnt(0)" ::: "memory");
}
#define XB_TMO      128
#define XB_XCNT(j)  (256  + 64 * (j))
#define XB_XSUB(j)  (1280 + 64 * (j))
#define XB_XGEN(j)  (2304 + 64 * (j))
#define XB_TOP      3328
#define XB_TOPGEN   3392
#define XCD_BAR_WORDS 3456
#define XB_SPIN_CAP (1u << 18)

__device__ __forceinline__ unsigned xb_ld(unsigned* p)              { return __hip_atomic_load(p, __ATOMIC_RELAXED, __HIP_MEMORY_SCOPE_AGENT); }
__device__ __forceinline__ unsigned xb_add(unsigned* p, unsigned v) { return __hip_atomic_fetch_add(p, v, __ATOMIC_RELAXED, __HIP_MEMORY_SCOPE_AGENT); }
__device__ __forceinline__ unsigned xb_xcc_id() { return (unsigned)__builtin_amdgcn_s_getreg((3 << 11) | 20) & 0xFu; }
#define XB_SPIN(cond, bar) do { unsigned _sp = 0; while (cond) { __builtin_amdgcn_s_sleep(1); \
    if ((++_sp & 255u) == 0u) { if (xb_ld(&(bar)[XB_TMO])) break; if (_sp > XB_SPIN_CAP) { atomicAdd(&(bar)[XB_TMO], 1u); break; } } } } while (0)

struct XcdBarrier {
    unsigned* bar; unsigned x;
    volatile LAS unsigned* st;
};

__device__ __forceinline__ XcdBarrier xcd_barrier_post(unsigned* bar, volatile LAS unsigned* st) {
    XcdBarrier b; b.bar = bar; b.x = xb_xcc_id(); b.st = st;
    if (threadIdx.x == 0) (void)xb_add(&bar[XB_XCNT(b.x)], 1u);
    return b;
}
__device__ __forceinline__ void xcd_barrier_complete(unsigned* bar, unsigned x, unsigned& nloc, unsigned& nx) {
    const unsigned G = gridDim.x * gridDim.y * gridDim.z;
    unsigned sum, cnt, mine, sp = 0u;
    for (;;) {
        sum = 0u; cnt = 0u; mine = 0u;
#pragma unroll 1
        for (unsigned j = 0; j < 16; ++j) { const unsigned c = xb_ld(&bar[XB_XCNT(j)]); sum += c; cnt += (c > 0u) ? 1u : 0u; mine = (j == x) ? c : mine; }
        if (sum == G) break;
        __builtin_amdgcn_s_sleep(1);
        if ((++sp & 255u) == 0u) { if (xb_ld(&bar[XB_TMO])) break; if (sp > XB_SPIN_CAP) { atomicAdd(&bar[XB_TMO], 1u); break; } }
    }
    nloc = mine > 0u ? mine : 1u; nx = cnt > 0u ? cnt : 1u;
}

__device__ __forceinline__ void xcd_barrier(const XcdBarrier& b) {
    asm volatile("s_waitcnt vmcnt(0)" ::: "memory");
    __syncthreads();
    if (threadIdx.x == 0) {
        unsigned* bar = b.bar;
        __builtin_amdgcn_s_waitcnt(0);
        unsigned nloc = b.st[0], nx = b.st[1];
        if (nloc == 0u) { xcd_barrier_complete(bar, b.x, nloc, nx); b.st[0] = nloc; b.st[1] = nx; }
        const unsigned old = xb_add(&bar[XB_XSUB(b.x)], 1u);
        const unsigned gen = old / nloc;
        if (old + 1u == (gen + 1u) * nloc) {
            __builtin_amdgcn_fence(__ATOMIC_RELEASE, "agent");
            asm volatile("s_waitcnt vmcnt(0)" ::: "memory");
            const unsigned og = xb_add(&bar[XB_TOP], 1u);
            const unsigned tg = og / nx;
            if (og + 1u == (tg + 1u) * nx) xb_add(&bar[XB_TOPGEN], 1u);
            else XB_SPIN(xb_ld(&bar[XB_TOPGEN]) == tg, bar);
            __builtin_amdgcn_fence(__ATOMIC_ACQUIRE, "agent");
            xb_add(&bar[XB_XGEN(b.x)], 1u);
            asm volatile("s_waitcnt vmcnt(0)" ::: "memory");
        } else {
            XB_SPIN(xb_ld(&bar[XB_XGEN(b.x)]) == gen, bar);
            __builtin_amdgcn_fence(__ATOMIC_ACQUIRE, "agent");
            asm volatile("s_waitcnt vmcnt(0)" ::: "memory");
        }
    }
    __syncthreads();
}

struct KArgs { const float* in[38]; float* out; unsigned char* ws; int ph_lo, ph_hi; };
typedef const __attribute__((address_space(4))) KArgs& KArgsR;
typedef const __attribute__((address_space(4))) KArgs* KArgsP;
__device__ __forceinline__ KArgsP opaque_kargs(KArgsP p) {
    const unsigned long long v = (unsigned long long)p; unsigned lo = (unsigned)v, hi = (unsigned)(v >> 32);
    asm volatile("" : "+s"(lo), "+s"(hi));
    lo = __builtin_amdgcn_readfirstlane(lo); hi = __builtin_amdgcn_readfirstlane(hi);
    return (KArgsP)(((unsigned long long)hi << 32) | lo);
}

__device__ __forceinline__ void p0_phase(KArgsR a, LAS unsigned char* lds, int tid, int lane, int wid) {
    const int G = gridDim.x, bid = blockIdx.x;
    const int gw = bid * 8 + wid, ngw = G * 8;
    {
        LAS float* sl = (LAS float*)(lds + 69632);
        LAS float* red = (LAS float*)(lds + 90112);
        const float* c = a.in[1]; const float* cctx = a.in[3]; const float* ada_w = a.in[4]; const float* ada_b = a.in[5];
        float* MODS = (float*)(a.ws + WS_MODS);
        for (int idx = tid; idx < 5 * 1024; idx += NTHR) { const int s = idx >> 10, k = idx & 1023; const float x = s < 4 ? c[s * 1024 + k] : cctx[k]; sl[idx] = x / (1.0f + __expf(-x)); }
        __syncthreads();
        for (int item = bid; item < 384; item += G) {
            const int i = item / 96, cgp = item % 96;
            const float* W = ada_w + (size_t)i * 1024 * 6144 + cgp * 64 + lane;
            float acc[5] = {0.f, 0.f, 0.f, 0.f, 0.f};
            const int k0 = wid * 128;
#pragma unroll 8
            for (int kk = 0; kk < 128; ++kk) {
                const float w = W[(size_t)(k0 + kk) * 6144];
#pragma unroll
                for (int s = 0; s < 5; ++s) acc[s] += sl[s * 1024 + k0 + kk] * w;
            }
#pragma unroll
            for (int s = 0; s < 5; ++s) red[(wid * 5 + s) * 64 + lane] = acc[s];
            __syncthreads();
            if (tid < 320) {
                const int s = tid >> 6, l = tid & 63; float sum = ada_b[i * 6144 + cgp * 64 + l];
#pragma unroll
                for (int w = 0; w < 8; ++w) sum += red[(w * 5 + s) * 64 + l];
                MODS[(size_t)(i * 5 + s) * 6144 + cgp * 64 + l] = sum;
            }
            __syncthreads();
        }
    }
    {
        LAS float* scr = (LAS float*)(lds + wid * 8448);
        bf16_t* WB = (bf16_t*)(a.ws + WS_WB);
        for (int mi = 0; mi < 16; ++mi) {
            const float* W; int K, N; bf16_t* WT;
            if (mi < 4)       { W = a.in[8]  + (size_t)mi * 1024 * 4096;        K = 1024; N = 4096; WT = WB + WB_W1 + (size_t)mi * 4096 * 1024; }
            else if (mi < 8)  { W = a.in[9]  + (size_t)(mi - 4) * 4096 * 1024;  K = 4096; N = 1024; WT = WB + WB_W2 + (size_t)(mi - 4) * 4096 * 1024; }
            else if (mi < 10) { W = a.in[11] + (size_t)(mi - 8) * 1024 * 3072;  K = 1024; N = 3072; WT = WB + WB_EVIN + (size_t)(mi - 8) * 3072 * 1024; }
            else if (mi < 12) { W = a.in[12] + (size_t)(mi - 10) * 1024 * 1024; K = 1024; N = 1024; WT = WB + WB_EVOUT + (size_t)(mi - 10) * 1024 * 1024; }
            else if (mi < 14) { W = a.in[29] + (size_t)(mi - 12) * 1024 * 2560; K = 1024; N = 2560; WT = WB + WB_ODIN + (size_t)(mi - 12) * 2560 * 1024; }
            else              { W = a.in[30] + (size_t)(mi - 14) * 1280 * 1024; K = 1280; N = 1024; WT = WB + WB_ODOUT + (size_t)(mi - 14) * 1024 * 1280; }
            const int nit = (K / 64) * (N / 32);
            for (int it = gw; it < nit; it += ngw) transpose_item(W, K, N, WT, scr, it, lane);
        }
    }
    {
        bf16_t* WSC = (bf16_t*)(a.ws + WS_WSC);
        for (int it = bid; it < 128; it += G) {
            const int mat = it & 1, jdn = it >> 1;
            const float* W = (mat ? a.in[35] : a.in[33]) + (size_t)jdn * 6400;
            bf16_t* O = WSC + (size_t)it * 7680;
            for (int idx = tid; idx < 7680; idx += NTHR) { const int dp = idx / 96, c = idx % 96; O[idx] = (bf16_t)f2bf(c < 80 ? W[c * 80 + dp] : 0.f); }
        }
    }
    {
        _Float16* H2 = (_Float16*)(a.ws + WS_H2);
        for (int rowi = gw; rowi < 2 * 8448; rowi += ngw) {
            const int j = rowi / 8448, p = rowi % 8448;
            const float* w1 = a.in[15] + j * 33 * 64; const float* b1 = a.in[16] + j * 64; const float* w2 = a.in[17] + j * 64 * 64; const float* b2 = a.in[18] + j * 64;
            const float fq = a.in[21][j * 64 + lane];
            int pp, L; if (p < 8192) { pp = p; L = 8192; } else { pp = p - 8192; L = 256; }
            const float invL = 1.0f / (float)L;
            const float t = (float)pp * invL;
            float z = b1[lane] + t * w1[lane];
#pragma unroll 4
            for (int n = 1; n <= 16; ++n) {
                const float rv = (float)((pp * n) & (L - 1)) * invL;
                z += cos_rev(rv) * w1[n * 64 + lane] + sin_rev(rv) * w1[(16 + n) * 64 + lane];
            }
            const float h1 = fsin(fq * z);
            float z2 = b2[lane];
#pragma unroll 8
            for (int k = 0; k < 64; ++k) z2 += __builtin_bit_cast(float, __builtin_amdgcn_readlane(__builtin_bit_cast(int, h1), k)) * w2[k * 64 + lane];
            H2[(size_t)rowi * 64 + lane] = (_Float16)fsin(fq * z2);
        }
    }
}

__device__ __forceinline__ cf2 cmul(cf2 a, cf2 b) { return MKCF(a.x * b.x - a.y * b.y, a.x * b.y + a.y * b.x); }
__device__ __forceinline__ void fft_fwd(LAS cf2* X, int tid) {
#pragma unroll 1
    for (int s = 0; s < 7; ++s) {
        const int lq = 12 - 2 * s, q = 1 << lq;
        const float rs = __builtin_bit_cast(float, (unsigned)(127 - (lq + 2)) << 23);
        if (lq > 9) {
#pragma unroll 2
            for (int i = 0; i < 8; ++i) {
                const int bf = tid + NTHR * i, j = bf & (q - 1), i0 = ((bf >> lq) << (lq + 2)) + j;
                const cf2 x0 = X[i0], x1 = X[i0 + q], x2 = X[i0 + 2 * q], x3 = X[i0 + 3 * q];
                const float rv = (float)j * rs;
                const cf2 w1 = MKCF(cos_rev(rv), -sin_rev(rv)), w2 = cmul(w1, w1), w3 = cmul(w2, w1);
                const cf2 A = MKCF(x0.x + x2.x, x0.y + x2.y), B = MKCF(x0.x - x2.x, x0.y - x2.y), C = MKCF(x1.x + x3.x, x1.y + x3.y), D = MKCF(x1.x - x3.x, x1.y - x3.y);
                X[i0] = MKCF(A.x + C.x, A.y + C.y);
                X[i0 + q] = cmul(MKCF(B.x + D.y, B.y - D.x), w1);
                X[i0 + 2 * q] = cmul(MKCF(A.x - C.x, A.y - C.y), w2);
                X[i0 + 3 * q] = cmul(MKCF(B.x - D.y, B.y + D.x), w3);
            }
        } else {
            const int j = tid & (q - 1);
            const float rv = (float)j * rs;
            const cf2 w1 = MKCF(cos_rev(rv), -sin_rev(rv)), w2 = cmul(w1, w1), w3 = cmul(w2, w1);
#pragma unroll 4
            for (int i = 0; i < 8; ++i) {
                const int bf = tid + NTHR * i, i0 = ((bf >> lq) << (lq + 2)) + j;
                const cf2 x0 = X[i0], x1 = X[i0 + q], x2 = X[i0 + 2 * q], x3 = X[i0 + 3 * q];
                const cf2 A = MKCF(x0.x + x2.x, x0.y + x2.y), B = MKCF(x0.x - x2.x, x0.y - x2.y), C = MKCF(x1.x + x3.x, x1.y + x3.y), D = MKCF(x1.x - x3.x, x1.y - x3.y);
                X[i0] = MKCF(A.x + C.x, A.y + C.y);
                X[i0 + q] = cmul(MKCF(B.x + D.y, B.y - D.x), w1);
                X[i0 + 2 * q] = cmul(MKCF(A.x - C.x, A.y - C.y), w2);
                X[i0 + 3 * q] = cmul(MKCF(B.x - D.y, B.y + D.x), w3);
            }
        }
        __syncthreads();
    }
}
__device__ __forceinline__ void fft_inv(LAS cf2* X, int tid) {
#pragma unroll 1
    for (int s = 6; s >= 0; --s) {
        const int lq = 12 - 2 * s, q = 1 << lq;
        const float rs = __builtin_bit_cast(float, (unsigned)(127 - (lq + 2)) << 23);
        if (lq > 9) {
#pragma unroll 2
            for (int i = 0; i < 8; ++i) {
                const int bf = tid + NTHR * i, j = bf & (q - 1), i0 = ((bf >> lq) << (lq + 2)) + j;
                const float rv = (float)j * rs;
                const cf2 w1 = MKCF(cos_rev(rv), sin_rev(rv)), w2 = cmul(w1, w1), w3 = cmul(w2, w1);
                const cf2 u0 = X[i0], u1 = cmul(X[i0 + q], w1), u2 = cmul(X[i0 + 2 * q], w2), u3 = cmul(X[i0 + 3 * q], w3);
                const cf2 A = MKCF(u0.x + u2.x, u0.y + u2.y), B = MKCF(u0.x - u2.x, u0.y - u2.y), C = MKCF(u1.x + u3.x, u1.y + u3.y), D = MKCF(u1.x - u3.x, u1.y - u3.y);
                X[i0] = MKCF(A.x + C.x, A.y + C.y);
                X[i0 + q] = MKCF(B.x - D.y, B.y + D.x);
                X[i0 + 2 * q] = MKCF(A.x - C.x, A.y - C.y);
                X[i0 + 3 * q] = MKCF(B.x + D.y, B.y - D.x);
            }
        } else {
            const int j = tid & (q - 1);
            const float rv = (float)j * rs;
            const cf2 w1 = MKCF(cos_rev(rv), sin_rev(rv)), w2 = cmul(w1, w1), w3 = cmul(w2, w1);
#pragma unroll 4
            for (int i = 0; i < 8; ++i) {
                const int bf = tid + NTHR * i, i0 = ((bf >> lq) << (lq + 2)) + j;
                const cf2 u0 = X[i0], u1 = cmul(X[i0 + q], w1), u2 = cmul(X[i0 + 2 * q], w2), u3 = cmul(X[i0 + 3 * q], w3);
                const cf2 A = MKCF(u0.x + u2.x, u0.y + u2.y), B = MKCF(u0.x - u2.x, u0.y - u2.y), C = MKCF(u1.x + u3.x, u1.y + u3.y), D = MKCF(u1.x - u3.x, u1.y - u3.y);
                X[i0] = MKCF(A.x + C.x, A.y + C.y);
                X[i0 + q] = MKCF(B.x - D.y, B.y + D.x);
                X[i0 + 2 * q] = MKCF(A.x - C.x, A.y - C.y);
                X[i0 + 3 * q] = MKCF(B.x + D.y, B.y - D.x);
            }
        }
        __syncthreads();
    }
}
__device__ __forceinline__ void mul_spectrum(LAS cf2* X, const unsigned* KH, float bias, int tid) {
#pragma unroll 4
    for (int i = 0; i < 32; ++i) {
        const int p = tid + NTHR * i;
        const h16x2 kh = __builtin_bit_cast(h16x2, KH[p]);
        X[p] = cmul(X[p], MKCF((float)kh.x + bias, (float)kh.y));
    }
    __syncthreads();
}

typedef _Float16 f16x8 __attribute__((ext_vector_type(8)));
__device__ __forceinline__ int rev4_14(int x) { const unsigned r = __builtin_bitreverse32((unsigned)x) >> 18; return (int)(((r & 0x2AAAu) >> 1) | ((r & 0x1555u) << 1)); }
__device__ __forceinline__ void khat_item(KArgsR a, LAS unsigned char* lds, int j, int c, int tid) {
    LAS cf2* X = (LAS cf2*)lds; LAS float* Xf = (LAS float*)lds;
    const int lane = tid & 63, wid = tid >> 6, r = lane & 31, h = lane >> 5;
    const float* w3 = a.in[19] + (size_t)j * 64 * 2048; const float* b3 = a.in[20] + j * 2048; const float* decay = a.in[22] + (size_t)j * 2048;
    const _Float16* H2 = (const _Float16*)(a.ws + WS_H2) + (size_t)j * 8448 * 64;
    unsigned* KH = (unsigned*)(a.ws + WS_BIG + BIG_KH);
    const int o = (r >> 1) & 1, dir = r & 1;
    const int col = o * 1024 + dir * 512 + c;
    f16x8 bfr[4];
#pragma unroll
    for (int ks = 0; ks < 4; ++ks)
#pragma unroll
        for (int jj = 0; jj < 8; ++jj) bfr[ks][jj] = (r < 4) ? (_Float16)w3[(size_t)(16 * ks + 8 * h + jj) * 2048 + col] : (_Float16)0.f;
    const float bb = b3[col], dsc = fabsf(decay[col]) * (1.4426950408889634f / 8192.0f);
    if (tid == 0) X[8192] = MKCF(0.f, 0.f);
#pragma unroll 4
    for (int ti = 0; ti < 32; ++ti) {
        const int tl = wid + 8 * ti;
        f32x16 acc;
#pragma unroll
        for (int i = 0; i < 16; ++i) acc[i] = 0.f;
#pragma unroll
        for (int ks = 0; ks < 4; ++ks) {
            const f16x8 af = *(const f16x8*)(H2 + (size_t)(32 * tl + r) * 64 + 16 * ks + 8 * h);
            acc = __builtin_amdgcn_mfma_f32_32x32x16_f16(af, bfr[ks], acc, 0, 0, 0);
        }
        if (r < 4) {
#pragma unroll
            for (int i = 0; i < 16; ++i) {
                const int p = 32 * tl + (i & 3) + 8 * (i >> 2) + 4 * h;
                const float val = (acc[i] + bb) * __builtin_amdgcn_exp2f(-(float)p * dsc);
                if (dir == 0) Xf[2 * p + o] = val;
                else if (p != 0) Xf[2 * (16384 - p) + o] = val;
            }
        }
    }
    __syncthreads();
    fft_fwd(X, tid);
#pragma unroll 4
    for (int i = 0; i < 32; ++i) {
        const int p = tid + NTHR * i;
        const int k = rev4_14(p), pm = rev4_14((16384 - k) & 16383);
        const cf2 z = X[p], zm = X[pm];
        h16x2 k0, k1;
        k0.x = (_Float16)(0.5f * (z.x + zm.x)); k0.y = (_Float16)(0.5f * (z.y - zm.y));
        k1.x = (_Float16)(0.5f * (z.y + zm.y)); k1.y = (_Float16)(0.5f * (zm.x - z.x));
        KH[(size_t)c * 16384 + p] = __builtin_bit_cast(unsigned, k0);
        KH[(size_t)(512 + c) * 16384 + p] = __builtin_bit_cast(unsigned, k1);
    }
    __syncthreads();
}

__device__ __forceinline__ float conv3_at(const bf16_t* p, int t, float w0, float w1, float w2, float bs) {
    const float l = t > 0 ? bf2f(p[t - 1]) : 0.f, m = bf2f(p[t]), r = t < 8191 ? bf2f(p[t + 1]) : 0.f;
    return w0 * l + w1 * m + w2 * r + bs;
}
__device__ __forceinline__ void conv3_pair(const bf16_t* p, int t2, float w0, float w1, float w2, float bs, float (&o)[2]) {
    const unsigned wm = *(const unsigned*)(p + t2);
    const unsigned wl = t2 > 0 ? *(const unsigned*)(p + t2 - 2) : 0u, wr = t2 < 8190 ? *(const unsigned*)(p + t2 + 2) : 0u;
    const float xm1 = __builtin_bit_cast(float, wl & 0xffff0000u), x0 = __builtin_bit_cast(float, wm << 16), x1 = __builtin_bit_cast(float, wm & 0xffff0000u), x2 = __builtin_bit_cast(float, wr << 16);
    o[0] = w0 * xm1 + w1 * x0 + w2 * x1 + bs; o[1] = w0 * x0 + w1 * x1 + w2 * x2 + bs;
}
__device__ __forceinline__ void hyena_lat_item(KArgsR a, LAS unsigned char* lds, int j, int c, int pair, int tid) {
    LAS cf2* X = (LAS cf2*)lds;
    const bf16_t* UT = (const bf16_t*)(a.ws + WS_BIG + BIG_U);
    const unsigned* KH = (const unsigned*)(a.ws + WS_BIG + BIG_KH);
    bf16_t* ACT = (bf16_t*)(a.ws + WS_ACT);
    const float* sw = a.in[13] + (size_t)j * 3 * 1536; const float* sb = a.in[14] + j * 1536; const float* hbias = a.in[23] + j * 1024;
    const int b0 = 2 * pair;
    const bf16_t* V0 = UT + ((size_t)b0 * 1536 + c) * 8192; const bf16_t* V1 = V0 + (size_t)1536 * 8192;
    const float wv0 = sw[c], wv1 = sw[1536 + c], wv2 = sw[3072 + c], bv = sb[c];
    const float wa0 = sw[512 + c], wa1 = sw[1536 + 512 + c], wa2 = sw[3072 + 512 + c], ba_ = sb[512 + c];
    const float wb0 = sw[1024 + c], wb1 = sw[1536 + 1024 + c], wb2 = sw[3072 + 1024 + c], bb_ = sb[1024 + c];
    const float bias0 = hbias[c], bias1 = hbias[512 + c];
#pragma unroll 4
    for (int i = 0; i < 8; ++i) {
        const int t2 = 2 * tid + 1024 * i;
        const unsigned w0 = *(const unsigned*)(V0 + t2), w1 = *(const unsigned*)(V1 + t2);
        f32x4 o; o.x = __builtin_bit_cast(float, w0 << 16); o.y = __builtin_bit_cast(float, w1 << 16); o.z = __builtin_bit_cast(float, w0 & 0xffff0000u); o.w = __builtin_bit_cast(float, w1 & 0xffff0000u);
        *(LAS f32x4*)(X + t2) = o;
    }
    __syncthreads();
#pragma unroll 2
    for (int i = 0; i < 16; ++i) {
        const int t = tid + NTHR * i;
        const cf2 l = t > 0 ? X[t - 1] : MKCF(0.f, 0.f), m = X[t], r = t < 8191 ? X[t + 1] : MKCF(0.f, 0.f);
        X[8192 + t] = MKCF(wv0 * l.x + wv1 * m.x + wv2 * r.x + bv, wv0 * l.y + wv1 * m.y + wv2 * r.y + bv);
    }
    __syncthreads();
#pragma unroll 2
    for (int i = 0; i < 16; ++i) { const int t = tid + NTHR * i; X[t] = X[8192 + t]; X[8192 + t] = MKCF(0.f, 0.f); }
    __syncthreads();
    fft_fwd(X, tid);
    mul_spectrum(X, KH + (size_t)c * 16384, bias0, tid);
    fft_inv(X, tid);
    {
        const bf16_t* A0 = V0 + (size_t)512 * 8192; const bf16_t* A1 = V1 + (size_t)512 * 8192;
#pragma unroll 2
        for (int i = 0; i < 8; ++i) {
            const int t2 = 2 * tid + 1024 * i;
            float xa[2], xb[2];
            conv3_pair(A0, t2, wa0, wa1, wa2, ba_, xa); conv3_pair(A1, t2, wa0, wa1, wa2, ba_, xb);
            const f32x4 y = *(const LAS f32x4*)(X + t2);
            f32x4 o; o.x = xa[0] * y.x * (1.0f / 16384.0f); o.y = xb[0] * y.y * (1.0f / 16384.0f); o.z = xa[1] * y.z * (1.0f / 16384.0f); o.w = xb[1] * y.w * (1.0f / 16384.0f);
            *(LAS f32x4*)(X + t2) = o; *(LAS f32x4*)(X + 8192 + t2) = (f32x4){0.f, 0.f, 0.f, 0.f};
        }
    }
    __syncthreads();
    fft_fwd(X, tid);
    mul_spectrum(X, KH + (size_t)(512 + c) * 16384, bias1, tid);
    fft_inv(X, tid);
    {
        const bf16_t* B0 = V0 + (size_t)1024 * 8192; const bf16_t* B1 = V1 + (size_t)1024 * 8192;
#pragma unroll 2
        for (int i = 0; i < 8; ++i) {
            const int t2 = 2 * tid + 1024 * i;
            float xa[2], xb[2];
            conv3_pair(B0, t2, wb0, wb1, wb2, bb_, xa); conv3_pair(B1, t2, wb0, wb1, wb2, bb_, xb);
            const f32x4 y = *(const LAS f32x4*)(X + t2);
            ACT[(size_t)(b0 * 8192 + t2) * 1024 + c] = (bf16_t)f2bf(xa[0] * y.x * (1.0f / 16384.0f));
            ACT[(size_t)((b0 + 1) * 8192 + t2) * 1024 + c] = (bf16_t)f2bf(xb[0] * y.y * (1.0f / 16384.0f));
            ACT[(size_t)(b0 * 8192 + t2 + 1) * 1024 + c] = (bf16_t)f2bf(xa[1] * y.z * (1.0f / 16384.0f));
            ACT[(size_t)((b0 + 1) * 8192 + t2 + 1) * 1024 + c] = (bf16_t)f2bf(xb[1] * y.w * (1.0f / 16384.0f));
        }
    }
    __syncthreads();
}

__device__ __forceinline__ void hyena_ctx_item(KArgsR a, LAS unsigned char* lds, int j, int c, int tid) {
    LAS float* ks = (LAS float*)lds;
    LAS float* vc = ks + 1024;
    LAS float* zc = vc + 1024;
    LAS float* w3c = zc + 1024;
    const bf16_t* U = (const bf16_t*)(a.ws + WS_BIG + BIG_U);
    bf16_t* ACT = (bf16_t*)(a.ws + WS_ACT);
    const float* w3 = a.in[19] + (size_t)j * 64 * 2048; const float* b3 = a.in[20] + j * 2048; const float* decay = a.in[22] + (size_t)j * 2048;
    const _Float16* H2 = (const _Float16*)(a.ws + WS_H2) + ((size_t)j * 8448 + 8192) * 64;
    const float* sw = a.in[13] + (size_t)j * 3 * 1536; const float* sb = a.in[14] + j * 1536; const float* hbias = a.in[23] + j * 1024;
    if (tid < 256) w3c[tid] = w3[(size_t)(tid & 63) * 2048 + (tid >> 6) * 512 + c];
    if (tid < 2) ks[tid * 512] = 0.f;
    __syncthreads();
    float x1c[2], x2c[2];
#pragma unroll
    for (int k = 0; k < 2; ++k) {
        const int idx = tid + NTHR * k;
        {
            const int od = idx >> 8, p = idx & 255, col = od * 512 + c, o = od >> 1, dir = od & 1;
            const f16x8* hr = (const f16x8*)(H2 + (size_t)p * 64); float dot = 0.f;
#pragma unroll
            for (int u8 = 0; u8 < 8; ++u8) { const f16x8 hv = hr[u8];
#pragma unroll
                for (int e = 0; e < 8; ++e) dot += (float)hv[e] * w3c[od * 64 + u8 * 8 + e]; }
            const float val = (dot + b3[col]) * __expf(-(float)p * (1.0f / 256.0f) * fabsf(decay[col]));
            if (dir == 0) ks[o * 512 + 256 + p] = val; else if (p != 0) ks[o * 512 + 256 - p] = val;
        }
        {
            const int b = idx >> 8, t = idx & 255;
            float cv[3];
#pragma unroll
            for (int g = 0; g < 3; ++g) {
                const int ch = g * 512 + c;
                const bf16_t* Ur = U + (size_t)4 * 1536 * 8192 + ((size_t)b * 1536 + ch) * 256 + t;
                const float l = t > 0 ? bf2f(Ur[-1]) : 0.f, m = bf2f(Ur[0]), r = t < 255 ? bf2f(Ur[1]) : 0.f;
                cv[g] = sw[ch] * l + sw[1536 + ch] * m + sw[3072 + ch] * r + sb[ch];
            }
            vc[idx] = cv[0]; x1c[k] = cv[1]; x2c[k] = cv[2];
        }
    }
    __syncthreads();
    const float bias0 = hbias[c], bias1 = hbias[512 + c];
#pragma unroll
    for (int k = 0; k < 2; ++k) {
        const int idx = tid + NTHR * k, b = idx >> 8, t = idx & 255;
        float y = 0.f;
        const LAS float* kp = ks + 256 + t; const LAS f32x4* vp = (const LAS f32x4*)(vc + b * 256);
#pragma unroll 4
        for (int s4 = 0; s4 < 64; ++s4) { const f32x4 v = vp[s4]; y += kp[-4 * s4] * v.x + kp[-4 * s4 - 1] * v.y + kp[-4 * s4 - 2] * v.z + kp[-4 * s4 - 3] * v.w; }
        zc[idx] = x1c[k] * (y + vc[idx] * bias0);
    }
    __syncthreads();
#pragma unroll
    for (int k = 0; k < 2; ++k) {
        const int idx = tid + NTHR * k, b = idx >> 8, t = idx & 255;
        float y = 0.f;
        const LAS float* kp = ks + 512 + 256 + t; const LAS f32x4* vp = (const LAS f32x4*)(zc + b * 256);
#pragma unroll 4
        for (int s4 = 0; s4 < 64; ++s4) { const f32x4 v = vp[s4]; y += kp[-4 * s4] * v.x + kp[-4 * s4 - 1] * v.y + kp[-4 * s4 - 2] * v.z + kp[-4 * s4 - 3] * v.w; }
        ACT[(size_t)(ML + b * 256 + t) * 1024 + c] = (bf16_t)f2bf(x2c[k] * (y + zc[idx] * bias1));
    }
    __syncthreads();
}

#define MFMA32(a_, b_, c_) __builtin_amdgcn_mfma_f32_32x32x16_bf16((a_), (b_), (c_), 0, 0, 0)
#define MFMA16(a_, b_, c_) __builtin_amdgcn_mfma_f32_16x16x32_bf16((a_), (b_), (c_), 0, 0, 0)
__device__ __forceinline__ void attn_unit(KArgsR a, LAS unsigned char* lds, int b, int hh, int qrow0, int kt_lo, int kt_hi, float lam, float osc, const float* subg, int tid) {
    const int lane = tid & 63, wid = tid >> 6, r = lane & 31, h = lane >> 5;
    const bf16_t* Qb = (const bf16_t*)(a.ws + WS_BIG + BIG_Q); const bf16_t* Kb = (const bf16_t*)(a.ws + WS_BIG + BIG_K); const bf16_t* VT = (const bf16_t*)(a.ws + WS_BIG + BIG_VT);
    bf16_t* ACT = (bf16_t*)(a.ws + WS_ACT);
    const int qrow = qrow0 + wid * 32 + r;
    LAS unsigned* osl = (LAS unsigned*)(lds + 53248) + wid * 2048 + lane;
    const int kkey = tid >> 3, kch = tid & 7;
    const bf16_t* vbase = VT + (size_t)((b * 4 + hh) * 128) * NKEY + (size_t)(tid >> 3) * NKEY + (tid & 7) * 8;
#define ATT_LOAD(KR, V0, V1, kt_) do { const int ktt_ = (kt_); const int kb_ = ktt_ < 128 ? b * 8192 + ktt_ * 64 : ML + b * 256 + (ktt_ - 128) * 64; \
        KR = *(const u32x4*)(kcol + (size_t)(kb_ + kkey) * 512); V0 = *(const u32x4*)(vbase + ktt_ * 64); V1 = *(const u32x4*)(vbase + (size_t)64 * NKEY + ktt_ * 64); } while (0)
#define ATT_STORE(KR, V0, V1, slot_) do { LAS unsigned char* ks_ = lds + (slot_) * 26624; LAS unsigned char* vs_ = ks_ + 9216 + (tid >> 3) * 136 + (tid & 7) * 16; \
        *(LAS u32x4*)(ks_ + kkey * 144 + kch * 16) = KR; \
        { u32x2 w0_, w1_; w0_.x = V0.x; w0_.y = V0.y; w1_.x = V0.z; w1_.y = V0.w; *(LAS u32x2*)(vs_) = w0_; *(LAS u32x2*)(vs_ + 8) = w1_; } \
        { u32x2 w0_, w1_; w0_.x = V1.x; w0_.y = V1.y; w1_.x = V1.z; w1_.y = V1.w; *(LAS u32x2*)(vs_ + 64 * 136) = w0_; *(LAS u32x2*)(vs_ + 64 * 136 + 8) = w1_; } } while (0)
#pragma unroll 1
    for (int jj = 0; jj < 2; ++jj) {
        const bf16_t* kcol = Kb + hh * 128 + jj * 64 + kch * 8;
        bf16x8 qf[4];
#pragma unroll
        for (int ks = 0; ks < 4; ++ks) qf[ks] = *(const bf16x8*)(Qb + (size_t)qrow * 512 + hh * 128 + jj * 64 + ks * 16 + h * 8);
        f32x16 o[4];
#pragma unroll
        for (int et = 0; et < 4; ++et)
#pragma unroll
            for (int i = 0; i < 16; ++i) o[et][i] = 0.f;
        float mrun = -INFINITY, lrun = 0.f;
        u32x4 kA, vA0, vA1, kB, vB0, vB1;
        ATT_LOAD(kA, vA0, vA1, kt_lo); ATT_LOAD(kB, vB0, vB1, kt_lo + 1);
        ATT_STORE(kA, vA0, vA1, 0);
        if (kt_lo + 2 < kt_hi) ATT_LOAD(kA, vA0, vA1, kt_lo + 2);
#pragma unroll 1
        for (int kt2 = kt_lo; kt2 < kt_hi; kt2 += 2) {
#pragma unroll
            for (int par = 0; par < 2; ++par) {
                __syncthreads();
                if (par == 0) { ATT_STORE(kB, vB0, vB1, 1); if (kt2 + 3 < kt_hi) ATT_LOAD(kB, vB0, vB1, kt2 + 3); }
                else { if (kt2 + 2 < kt_hi) { ATT_STORE(kA, vA0, vA1, 0); } if (kt2 + 4 < kt_hi) ATT_LOAD(kA, vA0, vA1, kt2 + 4); }
                const LAS unsigned char* Kl = lds + par * 26624; const LAS unsigned char* Vl = Kl + 9216;
                f32x16 s0, s1;
#pragma unroll
                for (int i = 0; i < 16; ++i) { s0[i] = 0.f; s1[i] = 0.f; }
#pragma unroll
                for (int ks = 0; ks < 4; ++ks) {
                    const bf16x8 k0 = *(const LAS bf16x8*)(Kl + r * 144 + (ks * 16 + h * 8) * 2);
                    const bf16x8 k1 = *(const LAS bf16x8*)(Kl + (32 + r) * 144 + (ks * 16 + h * 8) * 2);
                    s0 = MFMA32(k0, qf[ks], s0); s1 = MFMA32(k1, qf[ks], s1);
                }
                float mx = s0[0];
#pragma unroll
                for (int i = 0; i < 16; ++i) { mx = fmaxf(mx, s0[i]); mx = fmaxf(mx, s1[i]); }
                mx = fmaxf(mx, shflx(mx, 32, lane));
                const float mnew = fmaxf(mrun, mx);
                const float alpha = __builtin_amdgcn_exp2f(mrun - mnew);
                float sum = 0.f;
#pragma unroll
                for (int i = 0; i < 16; ++i) { s0[i] = __builtin_amdgcn_exp2f(s0[i] - mnew); s1[i] = __builtin_amdgcn_exp2f(s1[i] - mnew); sum += s0[i] + s1[i]; }
                sum += shflx(sum, 32, lane);
                lrun = lrun * alpha + sum; mrun = mnew;
                if (__builtin_amdgcn_ballot_w64(alpha != 1.0f) != 0ull) {
#pragma unroll
                    for (int et = 0; et < 4; ++et)
#pragma unroll
                        for (int i = 0; i < 16; ++i) o[et][i] *= alpha;
                }
                __builtin_amdgcn_sched_barrier(0);
#pragma unroll
                for (int st = 0; st < 2; ++st)
#pragma unroll
                    for (int s = 0; s < 2; ++s) {
                        u32x4 pw;
                        if (st == 0) { pw.x = pk2(s0[8 * s + 0], s0[8 * s + 1]); pw.y = pk2(s0[8 * s + 2], s0[8 * s + 3]); pw.z = pk2(s0[8 * s + 4], s0[8 * s + 5]); pw.w = pk2(s0[8 * s + 6], s0[8 * s + 7]); }
                        else         { pw.x = pk2(s1[8 * s + 0], s1[8 * s + 1]); pw.y = pk2(s1[8 * s + 2], s1[8 * s + 3]); pw.z = pk2(s1[8 * s + 4], s1[8 * s + 5]); pw.w = pk2(s1[8 * s + 6], s1[8 * s + 7]); }
                        const bf16x8 pf = __builtin_bit_cast(bf16x8, pw);
                        u32x4 vw[4];
#pragma unroll
                        for (int et = 0; et < 4; ++et) {
                            const LAS unsigned char* vp = Vl + (32 * et + r) * 136 + (32 * st + 16 * s + 4 * h) * 2;
                            const u32x2 lo = *(const LAS u32x2*)vp, hi = *(const LAS u32x2*)(vp + 16);
                            vw[et].x = lo.x; vw[et].y = lo.y; vw[et].z = hi.x; vw[et].w = hi.y;
                        }
                        __builtin_amdgcn_s_setprio(1);
#pragma unroll
                        for (int et = 0; et < 4; ++et) o[et] = MFMA32(__builtin_bit_cast(bf16x8, vw[et]), pf, o[et]);
                        __builtin_amdgcn_s_setprio(0);
                        if (st * 2 + s == 1) __builtin_amdgcn_sched_barrier(0);
                    }
            }
        }
        const float inv = 1.0f / lrun;
        if (jj == 0) {
#pragma unroll
            for (int et = 0; et < 4; ++et)
#pragma unroll
                for (int i = 0; i < 8; ++i) osl[(et * 8 + i) * 64] = pk2(o[et][2 * i] * inv, o[et][2 * i + 1] * inv);
        } else {
            float ss = 0.f;
#pragma unroll
            for (int et = 0; et < 4; ++et)
#pragma unroll
                for (int i = 0; i < 16; ++i) { const unsigned pw0 = osl[(et * 8 + (i >> 1)) * 64]; const float p0 = __builtin_bit_cast(float, (i & 1) ? (pw0 & 0xffff0000u) : (pw0 << 16)); const float v = p0 - lam * (o[et][i] * inv); o[et][i] = v; ss += v * v; }
            ss += shflx(ss, 32, lane);
            const float rstd = rsqrtf(ss * (1.0f / 128.0f) + 1e-6f) * osc;
#pragma unroll
            for (int et = 0; et < 4; ++et)
#pragma unroll
                for (int g = 0; g < 4; ++g) {
                    const int e = 32 * et + 8 * g + 4 * h;
                    const f32x4 sg = *(const f32x4*)(subg + e);
                    u32x2 w; w.x = pk2(o[et][4 * g] * rstd * sg.x, o[et][4 * g + 1] * rstd * sg.y); w.y = pk2(o[et][4 * g + 2] * rstd * sg.z, o[et][4 * g + 3] * rstd * sg.w);
                    *(u32x2*)(ACT + (size_t)qrow * 1024 + 512 + hh * 128 + e) = w;
                }
        }
        __syncthreads();
    }
#undef ATT_LOAD
#undef ATT_STORE
}

__device__ __forceinline__ int scan_seq(int d, int k) { return d == 0 ? k : (k < 4 ? 3 - k : 135 - k); }
__device__ __forceinline__ float fsigm(float x) { return __builtin_amdgcn_rcpf(1.0f + __builtin_amdgcn_exp2f(-1.4426950408889634f * x)); }
__device__ __forceinline__ float fgelu(float g) { const float u = 0.7978845608028654f * (g + 0.044715f * g * g * g); return 0.5f * g * (2.0f - 2.0f * __builtin_amdgcn_rcpf(1.0f + __builtin_amdgcn_exp2f(2.8853900817779268f * u))); }
__device__ __forceinline__ void scan_chain(KArgsR a, LAS unsigned char* lds, int j, int cid, int tid) {
    const int d = tid >> 8, ht = tid & 255, lane = tid & 63, hw = (tid >> 6) & 3;
    const int q4 = cid & 3, n = (cid >> 2) & 15, b = cid >> 6;
    const int ch0 = n * 80, cq0 = ch0 + q4 * 20;
    LAS unsigned char* hb = lds + d * 69120;
    LAS float* xraw = (LAS float*)hb; LAS bf16_t* xcb = (LAS bf16_t*)(hb + 21504); LAS bf16_t* Wl = (LAS bf16_t*)(hb + 33792);
    LAS float* al = (LAS float*)(hb + 46080); LAS float* bl = (LAS float*)(hb + 54784); LAS float* hl = (LAS float*)(hb + 63488);
    const bf16_t* XG = (const bf16_t*)(a.ws + WS_BIG); bf16_t* ACT = (bf16_t*)(a.ws + WS_ACT);
    const bf16_t* WSC = (const bf16_t*)(a.ws + WS_WSC) + (size_t)(((j * 2 + d) * 16 + n) * 2) * 7680;
    const float* convw = a.in[31] + (size_t)j * 4 * 1280; const float* convb = a.in[32] + j * 1280;
    const float* ba = a.in[34] + j * 2560 + d * 1280; const float* bx = a.in[36] + j * 2560 + d * 1280; const float* lamp = a.in[37] + j * 2560 + d * 1280;
    for (int idx = ht; idx < 2 * 32 * 12; idx += 256) {
        const int mat = idx / 384, rem = idx % 384, dpl = rem / 12, ck = rem % 12;
        u32x4 v = {0u, 0u, 0u, 0u};
        if (dpl < 20) v = *(const u32x4*)(WSC + (size_t)mat * 7680 + (q4 * 20 + dpl) * 96 + ck * 8);
        *(LAS u32x4*)(Wl + mat * 3072 + dpl * 96 + ck * 8) = v;
    }
    for (int idx = ht; idx < 64 * 16; idx += 256) xcb[(idx >> 4) * 96 + 80 + (idx & 15)] = 0;
    float bav[2], bxv[2], spv[2]; bool val[2];
#pragma unroll
    for (int nt = 0; nt < 2; ++nt) {
        const int dp = 16 * nt + (lane & 15); val[nt] = dp < 20; const int gc = cq0 + (val[nt] ? dp : 0);
        bav[nt] = ba[gc]; bxv[nt] = bx[gc]; spv[nt] = log1pf(__expf(-lamp[gc]));
    }
    const int xrow = (ht / 40) % 6, cp = ht % 40;
    const int tr = (ht / 20) % 12, cgp = ht % 20;
    f32x4 cw4[4], cb4;
#pragma unroll
    for (int kk = 0; kk < 4; ++kk) cw4[kk] = *(const f32x4*)(convw + kk * 1280 + ch0 + 4 * cgp);
    cb4 = *(const f32x4*)(convb + ch0 + 4 * cgp);
    float hcar = 0.f;
    const int sth = ht - 64 * d;
    int otab[3];
#pragma unroll
    for (int r = 0; r < 3; ++r) { const int e = ht + 256 * r; otab[r] = ((e / 10) << 8) | (2 * (e % 10)); }
    unsigned xr[12];
    const bf16_t* xcol = XG + 1280 + ch0 + 2 * cp;
#define SC_PARAMS(S_, T0_, LS_, RB_, kk_) do { const int s__ = scan_seq(d, (kk_)); S_ = s__; if (s__ < 4) { T0_ = s__ * 64; LS_ = 256; RB_ = ML + b * 256; } else { T0_ = (s__ - 4) * 64; LS_ = 8192; RB_ = b * 8192; } } while (0)
#define SC_PREFETCH(T0_, LS_, RB_) do { _Pragma("unroll") for (int p = 0; p < 12; ++p) { int tt = xrow + 6 * p; tt = tt > 66 ? 66 : tt; int t = (T0_) + tt - 2; t = t < 0 ? 0 : (t >= (LS_) ? (LS_) - 1 : t); \
        xr[p] = *(const unsigned*)(xcol + (size_t)((RB_) + t) * 2560); } } while (0)
#define SC_STAGE(T0_, LS_) do { _Pragma("unroll") for (int p = 0; p < 12; ++p) { int tt = xrow + 6 * p; tt = tt > 66 ? 66 : tt; const int t = (T0_) + tt - 2; const unsigned xv = (t >= 0 && t < (LS_)) ? xr[p] : 0u; \
        *(LAS cf2*)(xraw + tt * 80 + 2 * cp) = MKCF(__builtin_bit_cast(float, xv << 16), __builtin_bit_cast(float, xv & 0xffff0000u)); } } while (0)
#define SC_CONV do { _Pragma("unroll") for (int p = 0; p < 6; ++p) { int tt = tr + 12 * p; tt = tt > 63 ? 63 : tt; f32x4 v = cb4; \
        _Pragma("unroll") for (int kk = 0; kk < 4; ++kk) v += cw4[kk] * *(const LAS f32x4*)(xraw + (tt + kk) * 80 + 4 * cgp); \
        u32x2 w; w.x = pk2(v.x, v.y); w.y = pk2(v.z, v.w); *(LAS u32x2*)(xcb + tt * 96 + 4 * cgp) = w; if (p & 1) __builtin_amdgcn_sched_barrier(0); } } while (0)
    int sA, t0A, LsA, rbA, sB = 0, t0B = 0, LsB = 1, rbB = 0;
    SC_PARAMS(sA, t0A, LsA, rbA, 0); SC_PREFETCH(t0A, LsA, rbA); SC_STAGE(t0A, LsA);
    SC_PARAMS(sB, t0B, LsB, rbB, 1); SC_PREFETCH(t0B, LsB, rbB);
    __syncthreads();
    SC_CONV;
    __syncthreads();
#pragma unroll 1
    for (int k = 0; k < NCH; ++k) {
        if (k + 1 < NCH) SC_STAGE(t0B, LsB);
        int sC = 0, t0C = 0, LsC = 1, rbC = 0;
        if (k + 2 < NCH) { SC_PARAMS(sC, t0C, LsC, rbC, k + 2); SC_PREFETCH(t0C, LsC, rbC); }
        {
            const int mt = hw;
            f32x4 ra[2], ri[2];
#pragma unroll
            for (int nt = 0; nt < 2; ++nt) { ra[nt] = (f32x4){0.f, 0.f, 0.f, 0.f}; ri[nt] = (f32x4){0.f, 0.f, 0.f, 0.f}; }
#pragma unroll
            for (int ks = 0; ks < 3; ++ks) {
                const bf16x8 af = *(const LAS bf16x8*)(xcb + (16 * mt + (lane & 15)) * 96 + 32 * ks + 8 * (lane >> 4));
#pragma unroll
                for (int nt = 0; nt < 2; ++nt) {
                    const bf16x8 wfa = *(const LAS bf16x8*)(Wl + (16 * nt + (lane & 15)) * 96 + 32 * ks + 8 * (lane >> 4));
                    const bf16x8 wfx = *(const LAS bf16x8*)(Wl + 3072 + (16 * nt + (lane & 15)) * 96 + 32 * ks + 8 * (lane >> 4));
                    ra[nt] = MFMA16(af, wfa, ra[nt]); ri[nt] = MFMA16(af, wfx, ri[nt]);
                }
            }
#pragma unroll
            for (int nt = 0; nt < 2; ++nt) {
                {
                    const int dp = 16 * nt + (lane & 15), tb = 16 * mt + 4 * (lane >> 4);
                    f32x4 av4, bv4;
#pragma unroll
                    for (int i = 0; i < 4; ++i) {
                        const float rg = fsigm(ra[nt][i] + bav[nt]), ig = fsigm(ri[nt][i] + bxv[nt]);
                        const float la = -8.0f * rg * spv[nt];
                        const float av = __builtin_amdgcn_exp2f(1.4426950408889634f * la);
                        const float em = fmaxf(1.0f - av * av, 0.f);
                        av4[i] = av;
                        bv4[i] = __builtin_amdgcn_sqrtf(em) * ig * bf2f(xcb[(tb + i) * 96 + q4 * 20 + dp]);
                    }
                    *(LAS f32x4*)(al + dp * 68 + tb) = av4; *(LAS f32x4*)(bl + dp * 68 + tb) = bv4;
                }
            }
        }
        __syncthreads();
        const int kother = (d == 0) ? (sA < 4 ? 3 - sA : 135 - sA) : sA;
        const bool first = k < kother, early = (k - kother) >= 2;
        unsigned pvr[3] = {0u, 0u, 0u}, ggr[3] = {0u, 0u, 0u};
        if (early) {
#pragma unroll
            for (int r = 0; r < 3; ++r) {
                const int e = ht + 256 * r;
                if (e < 640) {
                    const int tt = otab[r] >> 8, dp = otab[r] & 255; const size_t row = (size_t)(rbA + t0A + tt);
                    pvr[r] = __hip_atomic_load((unsigned*)(ACT + row * 1280 + cq0 + dp), __ATOMIC_RELAXED, __HIP_MEMORY_SCOPE_AGENT);
                    ggr[r] = *(const unsigned*)(XG + row * 2560 + cq0 + dp);
                }
            }
        }
        if (sth >= 0 && sth < 20) {
            float hv = hcar;
            if (d == 0) {
#pragma unroll 4
                for (int g = 0; g < 16; ++g) {
                    const f32x4 a4 = *(const LAS f32x4*)(al + sth * 68 + 4 * g), b4 = *(const LAS f32x4*)(bl + sth * 68 + 4 * g); f32x4 o4;
                    hv = a4.x * hv + b4.x; o4.x = hv; hv = a4.y * hv + b4.y; o4.y = hv; hv = a4.z * hv + b4.z; o4.z = hv; hv = a4.w * hv + b4.w; o4.w = hv;
                    *(LAS f32x4*)(hl + sth * 68 + 4 * g) = o4;
                }
            } else {
#pragma unroll 4
                for (int g = 15; g >= 0; --g) {
                    const f32x4 a4 = *(const LAS f32x4*)(al + sth * 68 + 4 * g), b4 = *(const LAS f32x4*)(bl + sth * 68 + 4 * g); f32x4 o4;
                    hv = a4.w * hv + b4.w; o4.w = hv; hv = a4.z * hv + b4.z; o4.z = hv; hv = a4.y * hv + b4.y; o4.y = hv; hv = a4.x * hv + b4.x; o4.x = hv;
                    *(LAS f32x4*)(hl + sth * 68 + 4 * g) = o4;
                }
            }
            hcar = hv;
        }
        if (k + 1 < NCH) SC_CONV;
        asm volatile("s_waitcnt vmcnt(12)" ::: "memory");
        __syncthreads();
        {
#pragma unroll
            for (int r = 0; r < 3; ++r) {
                const int e = ht + 256 * r;
                if (e < 640) {
                    const int tt = otab[r] >> 8, dp = otab[r] & 255; const size_t row = (size_t)(rbA + t0A + tt);
                    const float h0 = hl[dp * 68 + tt], h1 = hl[(dp + 1) * 68 + tt];
                    unsigned* ap = (unsigned*)(ACT + row * 1280 + cq0 + dp);
                    if (first) *ap = pk2(h0, h1);
                    else {
                        const unsigned prev = early ? pvr[r] : __hip_atomic_load(ap, __ATOMIC_RELAXED, __HIP_MEMORY_SCOPE_AGENT);
                        const unsigned gg = early ? ggr[r] : *(const unsigned*)(XG + row * 2560 + cq0 + dp);
                        const float p0 = __builtin_bit_cast(float, prev << 16), p1 = __builtin_bit_cast(float, prev & 0xffff0000u);
                        const float g0 = __builtin_bit_cast(float, gg << 16), g1 = __builtin_bit_cast(float, gg & 0xffff0000u);
                        *ap = pk2((p0 + h0) * fgelu(g0), (p1 + h1) * fgelu(g1));
                    }
                }
            }
        }
        sA = sB; t0A = t0B; LsA = LsB; rbA = rbB; sB = sC; t0B = t0C; LsB = LsC; rbB = rbC;
    }
    __syncthreads();
#undef SC_PARAMS
#undef SC_PREFETCH
#undef SC_STAGE
#undef SC_CONV
}

constexpr int NPHASE = 31;
#ifndef ONLY_KIND
#define ONLY_KIND -1
#endif
#define EN(k) (ONLY_KIND < 0 || ONLY_KIND == (k))
#ifdef PROBE_SUB
#define PROBE_SUBV PROBE_SUB
#else
#define PROBE_SUBV 0
#endif
#ifndef MK_MULTI
#define MK_MULTI 0
#endif
__global__ void __launch_bounds__(NTHR, 2) mega_fwd(KArgs a_by_value) {
    extern __shared__ __attribute__((aligned(16))) unsigned char lds_raw[];
    LAS unsigned char* lds = (LAS unsigned char*)lds_raw;
    cg::grid_group grid = cg::this_grid();
    const int tid0 = threadIdx.x;
    if (tid0 < 2) ((LAS unsigned*)(lds + LDS_BARST))[tid0] = 0u;
    __syncthreads();
    (void)xcd_barrier_post((unsigned*)(a_by_value.ws + WS_BAR), (volatile LAS unsigned*)(lds + LDS_BARST));
    const int G = gridDim.x, bid0 = blockIdx.x, ngw = G * 8;
    const int ph_lo = a_by_value.ph_lo, ph_hi = a_by_value.ph_hi;
#pragma unroll 1
#ifdef PROBE_KIND
    for (int pp = 2 * ph_lo; pp < 2 * ph_hi; ++pp) {
        const int ph = pp >> 1;
#else
    for (int ph = ph_lo; ph < ph_hi; ++ph) {
#endif
        const KArgsP ap = opaque_kargs((KArgsP)__builtin_amdgcn_kernarg_segment_ptr());

        KArgsR a = *ap;
#define KOPQ int tid = tid0; asm volatile("" : "+v"(tid)); const int lane = tid & 63, wid = __builtin_amdgcn_readfirstlane(tid >> 6); int bid = bid0; asm volatile("" : "+s"(bid)); bid = __builtin_amdgcn_readfirstlane(bid); (void)lane; int gw = bid * 8 + wid; asm volatile("" : "+v"(gw)); gw = __builtin_amdgcn_readfirstlane(gw); (void)gw; int i = iL; asm volatile("" : "+s"(i)); i = __builtin_amdgcn_readfirstlane(i); const int j = i >> 1; const bool even = (i & 1) == 0; const int Mrows = (i == 3) ? ML : MT; (void)j; (void)even; (void)Mrows; const KArgsP apb_ = opaque_kargs(ap); KArgsR a = *apb_; unsigned char* ws = a.ws; bf16_t* ACT = (bf16_t*)(ws + WS_ACT); bf16_t* BIG = (bf16_t*)(ws + WS_BIG); bf16_t* WB = (bf16_t*)(ws + WS_WB); bf16_t* HCTX = (bf16_t*)(ws + WS_HCTX); float* MODS = (float*)(ws + WS_MODS); bf16_t* H = (bf16_t*)((unsigned char*)a.out + 64 * MiB); const float* mods_i = MODS + (size_t)i * 5 * 6144; const float* srcLat = (i == 0) ? a.in[0] : nullptr; const float* srcCtx = (i == 0) ? a.in[2] : nullptr; (void)ACT; (void)BIG; (void)WB; (void)HCTX; (void)mods_i; (void)srcLat; (void)srcCtx; (void)H;
        int kind, iL = 0, sub = 0;
        if (ph == 0) kind = 0;
        else if (ph >= NPHASE - 2) { kind = 9; sub = ph - (NPHASE - 2); }
        else {
            const int q = ph - 1, st = q % 7; iL = q / 7;
            const bool ev = (iL & 1) == 0;
            kind = st == 0 ? 1 : st == 1 ? (ev ? 2 : 3) : st == 2 ? (ev ? 4 : 5) : st == 3 ? 7 : st == 4 ? 1 : st == 5 ? 3 : 7;
            sub = (st >= 4) ? 1 : 0;
        }
#ifdef PROBE_KIND
        if ((pp & 1) && kind != PROBE_KIND) continue;
#endif
        if (kind == 0 && EN(0)) { KOPQ
            p0_phase(a, lds, tid, lane, wid);
        } else if (kind == 1 && EN(1)) { KOPQ
            if (sub == 0) {
                norm_rows(srcLat, srcCtx, H, HCTX, a.in[6] + i * 1024, mods_i, 0, 1024, ACT, MT, gw, ngw, lane);
                if (even) { for (int it = bid; it < 512; it += G) khat_item(a, lds, j, it, tid); }
            } else {
                norm_rows(nullptr, nullptr, H, HCTX, a.in[7] + i * 1024, mods_i, 3072, 4096, ACT, Mrows, gw, ngw, lane);
            }
        } else if (kind == 2 && EN(2)) { KOPQ
            pg8::Gemm g{ACT, WB + WB_EVIN + (size_t)j * 3072 * 1024, MT, 3072, 1024}; pg8::StaticOrder S; S.init(MT, 3072, G, bid);
            EpiEvenIn E{(bf16_t*)(ws + WS_BIG + BIG_U), (bf16_t*)(ws + WS_BIG + BIG_Q), (bf16_t*)(ws + WS_BIG + BIG_K), (bf16_t*)(ws + WS_BIG + BIG_VT)};
            pg8::gemm_phase<EpiEvenIn, pg8::StaticOrder, true, true>(lds, g, S, E);
        } else if (kind == 3 && EN(3)) { KOPQ
            const int N = sub ? 4096 : 2560;
            const bf16_t* Bt = sub ? WB + WB_W1 + (size_t)i * 4096 * 1024 : WB + WB_ODIN + (size_t)j * 2560 * 1024;
            const int Mg = sub ? Mrows : MT;
            pg8::Gemm g{ACT, Bt, Mg, N, 1024}; pg8::StaticOrder S; S.init(Mg, N, G, bid);
            EpiStore E{BIG, N, sub};
            pg8::gemm_phase<EpiStore, pg8::StaticOrder, true, true>(lds, g, S, E);
        } else if (kind == 4 && EN(4)) { KOPQ
            const float s1 = wave_sum(a.in[24][j * 64 + lane] * a.in[25][j * 64 + lane], lane), s2 = wave_sum(a.in[26][j * 64 + lane] * a.in[27][j * 64 + lane], lane);
            const float lam_init = 0.8f - 0.6f * __expf(-0.3f * (float)i);
            const float lam = __expf(s1) - __expf(s2) + lam_init;
            const float* subg = a.in[28] + j * 128;
#ifdef PROBE_SUB
            const bool rep_ = (pp & 1);
#else
            const bool rep_ = false;
#endif
            if (!rep_ || PROBE_SUBV == 0)
            {
                const int vcu = (G % 8 == 0) ? (bid % 8) * (G / 8) + bid / 8 : bid;
                for (int it = vcu; it < 528; it += G) {
                    int b, hh, qrow0, ktlo;
                    if (it < 512) { b = it >> 7; hh = (it >> 5) & 3; qrow0 = b * 8192 + (it & 31) * 256; ktlo = 0; }
                    else { const int u = it - 512; b = u >> 2; hh = u & 3; qrow0 = ML + b * 256; ktlo = 128; }
                    attn_unit(a, lds, b, hh, qrow0, ktlo, 132, lam, 1.0f - lam_init, subg, tid);
                }
            }
            if (!rep_ || PROBE_SUBV == 1)
            {
                const bool xm = (G == 256);
                for (int it = bid; it < 1024; it += G) {
                    int c, pair;
                    if (xm) { const int rnd = it >> 8, xcd = bid & 7, slot = bid >> 3; c = rnd * 128 + xcd * 16 + (slot >> 1); pair = slot & 1; }
                    else { c = it >> 1; pair = it & 1; }
                    hyena_lat_item(a, lds, j, c, pair, tid);
                }
            }
            if (!rep_ || PROBE_SUBV == 2)
            for (int it = bid; it < 512; it += G) hyena_ctx_item(a, lds, j, it, tid);
        } else if (kind == 5 && EN(5)) { KOPQ
            for (int cid = bid; cid < 256; cid += G) scan_chain(a, lds, j, cid, tid);
        } else if (kind == 7 && EN(7)) { KOPQ
            const int K = sub ? 4096 : (even ? 1024 : 1280);
            const bf16_t* A = sub ? BIG : ACT;
            const bf16_t* Bt = sub ? WB + WB_W2 + (size_t)i * 4096 * 1024 : (even ? WB + WB_EVOUT + (size_t)j * 1024 * 1024 : WB + WB_ODOUT + (size_t)j * 1024 * 1280);
            pg8::Gemm g{A, Bt, Mrows, 1024, K}; pg8::StaticOrder S; S.init(Mrows, 1024, G, bid);
            EpiResid E{sub ? nullptr : srcLat, sub ? nullptr : srcCtx, H, HCTX, mods_i, sub ? 5120 : 2048};
            pg8::gemm_phase<EpiResid, pg8::StaticOrder, true, true>(lds, g, S, E);
        } else { KOPQ
            if (sub == 0) final_norm(H, a.out, (float*)(ws + WS_ACT), a.in[10], gw, ngw, lane);
            else final_copy((const float*)(ws + WS_ACT), a.out + (size_t)16384 * 1024, bid * NTHR + tid, G * NTHR);
        }
        #ifdef PROBE_SYNCS
        if (ph == 0) { for (int e = 0; e < PROBE_SYNCS; ++e) grid.sync(); }
#endif
#ifdef PROBE_KIND
        if (pp + 1 < 2 * ph_hi) grid.sync();
#else
        if (ph + 1 < ph_hi) { if (ph_hi > 4096) grid.sync(); else { XcdBarrier xb_; xb_.bar = (unsigned*)(ap->ws + WS_BAR); xb_.x = xb_xcc_id(); xb_.st = (volatile LAS unsigned*)(lds + LDS_BARST); xcd_barrier(xb_); } }
#endif
    }
}

extern "C" void kernel_launch(void* const* d_in, const int* in_sizes, int n_in, void* d_out, int out_size, void* d_ws, size_t ws_size, hipStream_t stream) {
    static int grid = 0;
    if (grid == 0) {
        if (n_in != 38 || in_sizes[0] != ML * DM || out_size != ML * DM || ws_size < WS_END) {
            fprintf(stderr, "kernel_launch: unexpected shapes: n_in %d in0 %d out %d ws %zu (need %zu)\n", n_in, n_in > 0 ? in_sizes[0] : -1, out_size, ws_size, (size_t)WS_END); grid = -1; return; }
        int dev = 0, cus = 0, per_cu = 0;
        (void)hipGetDevice(&dev); (void)hipDeviceGetAttribute(&cus, hipDeviceAttributeMultiprocessorCount, dev);
        if (hipFuncSetAttribute((const void*)mega_fwd, hipFuncAttributeMaxDynamicSharedMemorySize, LDS_BYTES) != hipSuccess) { fprintf(stderr, "kernel_launch: hipFuncSetAttribute failed\n"); grid = -1; return; }
        if (hipOccupancyMaxActiveBlocksPerMultiprocessor(&per_cu, (const void*)mega_fwd, NTHR, LDS_BYTES) != hipSuccess || per_cu < 1) { fprintf(stderr, "kernel_launch: occupancy query says %d\n", per_cu); per_cu = 1; }
        (void)hipGetLastError();
        grid = cus * 1;
        if (grid <= 0) grid = 256;
    }
    if (grid < 0) return;
    if (hipMemsetAsync((char*)d_ws + WS_BAR, 0, 16384, stream) != hipSuccess) { fprintf(stderr, "kernel_launch: memset of the barrier words failed\n"); return; }
    KArgs a{};
    for (int k = 0; k < 38; ++k) a.in[k] = (const float*)d_in[k];
    a.out = (float*)d_out; a.ws = (unsigned char*)d_ws;
#if MK_MULTI
    for (int p = 0; p < NPHASE; ++p) { a.ph_lo = p; a.ph_hi = p + 1; hipLaunchKernelGGL(mega_fwd, dim3(grid), dim3(NTHR), LDS_BYTES, stream, a); }
#else
    a.ph_lo = 0; a.ph_hi = NPHASE;
    void* args[] = {&a};
    hipError_t e = hipLaunchCooperativeKernel((const void*)mega_fwd, dim3(grid), dim3(NTHR), args, LDS_BYTES, stream);
    if (e != hipSuccess) fprintf(stderr, "kernel_launch: cooperative launch failed: %s (grid %d)\n", hipGetErrorString(e), grid);
#endif
}
```

```cpp
#include <hip/hip_runtime.h>
#include <hip/hip_cooperative_groups.h>
#include <cstdio>
#include <cstdint>
namespace cg = cooperative_groups;
namespace pg8 {
#define PG8_LAS __attribute__((address_space(3)))
typedef unsigned short bf16_t;
typedef short bf16x8 __attribute__((ext_vector_type(8)));
typedef float f32x4 __attribute__((ext_vector_type(4)));
typedef unsigned u32x4 __attribute__((ext_vector_type(4)));
constexpr int BM = 256, BK = 64, HALF = 128, HTB = HALF * BK * 2  , STAGE_BYTES = 8 * HTB, NXCD = 8, WGM = 8;

__host__ __device__ __forceinline__ int lds_byte(int r, int c) { const int st = (r >> 4) * 2 + (c >> 5), rr = r & 15, cc = c & 31, ob = rr * 64 + cc * 2; return st * 1024 + (ob ^ (((ob >> 9) & 1) << 5)); }
__host__ __device__ __forceinline__ void stage_rc(int b, int& R, int& C) { const int st = b / 1024, sb = b % 1024, swz = sb ^ (((sb >> 9) & 1) << 5); R = (st >> 1) * 16 + swz / 64; C = (st & 1) * 32 + (swz % 64) / 2; }
__host__ __device__ __forceinline__ int perm32(int rho) { const int n = rho >> 4, i = rho & 15; return 8 * (i >> 2) + 4 * n + (i & 3); }

struct Unit { int pm, pn; };
struct Gemm { const bf16_t* A; const bf16_t* Bt; int M, N, K; };

struct StaticOrder {
    int nM, nN, nwg, G, c;
    __host__ __device__ void init(int M, int N, int G_, int c_) { nM = M / BM; nN = N / BM; nwg = nM * nN; G = G_; c = c_; }
    __host__ __device__ bool next(int i, Unit& u) const {
        const long L = (long)i * G + c; if (L >= nwg) return false;
        int wgid = (int)L; { const int q = nwg / NXCD, r = nwg % NXCD, xcd = wgid % NXCD, off = wgid / NXCD; wgid = (xcd < r ? xcd * (q + 1) : r * (q + 1) + (xcd - r) * q) + off; }
        const int nig = WGM * nN, gid = wgid / nig, fm = gid * WGM, gsz = (nM - fm) < WGM ? (nM - fm) : WGM;
        u.pm = fm + ((wgid % nig) % gsz); u.pn = (wgid % nig) / gsz; return true;
    }
    __device__ __forceinline__ void a_ready(const Unit&) const {}
    __device__ __forceinline__ void done(const Unit&) const {}
};

__device__ __forceinline__ unsigned cvt_pk_bf16(float lo, float hi) { unsigned r; asm volatile("v_cvt_pk_bf16_f32 %0, %1, %2" : "=v"(r) : "v"(lo), "v"(hi)); return r; }
template <class Epi, class Sched, bool ALIGN_EPI = false, bool SP2 = false>
__device__ __forceinline__ void gemm_phase(PG8_LAS unsigned char* lds, const Gemm g, const Sched& S, const Epi& E) {
    int tid_op = threadIdx.x; asm volatile("" : "+v"(tid_op));
    const int tid = tid_op, wid = __builtin_amdgcn_readfirstlane(tid >> 6), lane = tid & 63, wr = wid >> 2, wc = wid & 3, fr = lane & 15, fq = lane >> 4;
    const int K = g.K, nt = K / BK;
    unsigned voffA[2], voffB[2];
#pragma unroll
    for (int i = 0; i < 2; ++i) { int R, C; stage_rc(tid * 16 + i * 8192, R, C); const int Rb = Epi::PERM ? ((R & ~31) + perm32(R & 31)) : R;
        voffA[i] = (unsigned)(R * K + C) * 2u; voffB[i] = (unsigned)(Rb * K + C) * 2u; }
    const size_t kstep = (size_t)(BK * 2);
    const size_t hstep = (size_t)HALF * K * 2;
    const size_t tstep = 2 * hstep;
    const unsigned ldsw = (unsigned)wid * 1024u;
    const int aoff = lds_byte(wr * 64 + fr, fq * 8), boff = lds_byte(wc * 32 + fr, fq * 8);
#define PG8_SA(b, h) (((b) * 2 + (h)) * HTB)
#define PG8_SB(b, h) ((4 + (b) * 2 + (h)) * HTB)
#define PG8_STAGE(bufoff, gbase, voff) do { _Pragma("unroll") for (int _i = 0; _i < 2; ++_i) \
        __builtin_amdgcn_global_load_lds((const unsigned*)((const char*)(gbase) + (voff)[_i]), (PG8_LAS unsigned*)(lds + (bufoff) + ldsw + _i * 8192), 16, 0, 0); } while (0)
#define PG8_LDA(dst, b, h) do { _Pragma("unroll") for (int m = 0; m < 4; ++m) _Pragma("unroll") for (int k = 0; k < 2; ++k) dst[m][k] = *(const PG8_LAS bf16x8*)(lds + PG8_SA(b, h) + aoff + m * 2048 + k * 1024); } while (0)
#define PG8_LDB(dst, b, h) do { _Pragma("unroll") for (int n = 0; n < 2; ++n) _Pragma("unroll") for (int k = 0; k < 2; ++k) dst[n][k] = *(const PG8_LAS bf16x8*)(lds + PG8_SB(b, h) + boff + n * 2048 + k * 1024); } while (0)
#define PG8_MMA(ai, bj, At, Bt) do { __builtin_amdgcn_s_setprio(1); _Pragma("unroll") for (int m = 0; m < 4; ++m) _Pragma("unroll") for (int n = 0; n < 2; ++n) _Pragma("unroll") for (int k = 0; k < 2; ++k) \
        acc[ai][bj][m][n] = __builtin_amdgcn_mfma_f32_16x16x32_bf16(Bt[n][k], At[m][k], acc[ai][bj][m][n], 0, 0, 0); __builtin_amdgcn_s_setprio(0); } while (0)
#define PG8_WAIT_V(n) asm volatile("s_waitcnt vmcnt(" #n ")" ::: "memory")
#define PG8_WAIT_L(n) asm volatile("s_waitcnt lgkmcnt(" #n ")" ::: "memory")
#define PG8_BAR __builtin_amdgcn_s_barrier()
#define PG8_SCHED __builtin_amdgcn_sched_barrier(0)
    Unit cur, nxt; int ui = 0;
    if (!S.next(0, cur)) return;
    f32x4 acc[2][2][4][2];
#pragma unroll
    for (int a = 0; a < 2; ++a)
#pragma unroll
        for (int b = 0; b < 2; ++b)
#pragma unroll
            for (int m = 0; m < 4; ++m)
#pragma unroll
                for (int n = 0; n < 2; ++n) acc[a][b][m][n] = (f32x4){0.f, 0.f, 0.f, 0.f};
    bf16x8 At[4][2], B0[2][2], B1[2][2];
    const char* cA = (const char*)g.A + (size_t)cur.pm * tstep; const char* cB = (const char*)g.Bt + (size_t)cur.pn * tstep;
    S.a_ready(cur);
    if constexpr (SP2) {
        PG8_STAGE(PG8_SB(0, 0), cB, voffB); PG8_STAGE(PG8_SB(0, 1), cB + hstep, voffB); PG8_STAGE(PG8_SA(0, 0), cA, voffA); PG8_STAGE(PG8_SA(0, 1), cA + hstep, voffA);
        if (wr == 1) PG8_BAR;
        PG8_WAIT_V(2); PG8_BAR;
        PG8_STAGE(PG8_SB(1, 0), cB + kstep, voffB); PG8_STAGE(PG8_SA(1, 0), cA + kstep, voffA); PG8_STAGE(PG8_SB(1, 1), cB + hstep + kstep, voffB);
        PG8_WAIT_V(6); PG8_BAR;
    } else {
        PG8_STAGE(PG8_SB(0, 0), cB, voffB); PG8_STAGE(PG8_SA(0, 0), cA, voffA); PG8_STAGE(PG8_SB(0, 1), cB + hstep, voffB); PG8_STAGE(PG8_SA(0, 1), cA + hstep, voffA);
        if (wr == 1) PG8_BAR;
        PG8_WAIT_V(4); PG8_BAR;
        PG8_STAGE(PG8_SB(1, 0), cB + kstep, voffB); PG8_STAGE(PG8_SA(1, 0), cA + kstep, voffA); PG8_STAGE(PG8_SB(1, 1), cB + hstep + kstep, voffB);
        PG8_WAIT_V(6); PG8_BAR;
    }
    for (;;) {
        const bool has_next = S.next(ui + 1, nxt);
        const char* nA = has_next ? (const char*)g.A + (size_t)nxt.pm * tstep : cA; const char* nB = has_next ? (const char*)g.Bt + (size_t)nxt.pn * tstep : cB;
        for (int t = 0; t < nt; t += 2) {
            const bool last = (t == nt - 2);
            const char* a1 = cA + (size_t)(t + 1) * kstep;
            const char* a2 = last ? nA : cA + (size_t)(t + 2) * kstep; const char* b2 = last ? nB : cB + (size_t)(t + 2) * kstep;
            const char* a3 = a2 + kstep; const char* b3 = b2 + kstep;
            if (last && has_next) S.a_ready(nxt);
            if constexpr (SP2) {
            PG8_LDB(B0, 0, 0); PG8_LDB(B1, 0, 1); PG8_SCHED; PG8_LDA(At, 0, 0); PG8_STAGE(PG8_SA(1, 1), a1 + hstep, voffA);
            PG8_WAIT_V(8); PG8_WAIT_L(0); PG8_BAR; PG8_MMA(0, 0, At, B0); PG8_MMA(0, 1, At, B1); PG8_BAR; PG8_SCHED;
            PG8_LDA(At, 0, 1); PG8_STAGE(PG8_SB(0, 0), b2, voffB); PG8_STAGE(PG8_SB(0, 1), b2 + hstep, voffB); PG8_STAGE(PG8_SA(0, 0), a2, voffA);
            PG8_WAIT_V(8); PG8_WAIT_L(0); PG8_BAR; PG8_MMA(1, 0, At, B0); PG8_MMA(1, 1, At, B1); PG8_BAR; PG8_SCHED;
            PG8_LDB(B0, 1, 0); PG8_LDB(B1, 1, 1); PG8_SCHED; PG8_LDA(At, 1, 0); PG8_STAGE(PG8_SA(0, 1), a2 + hstep, voffA);
            PG8_WAIT_V(8); PG8_WAIT_L(0); PG8_BAR; PG8_MMA(0, 0, At, B0); PG8_MMA(0, 1, At, B1); PG8_BAR; PG8_SCHED;
            PG8_LDA(At, 1, 1); PG8_STAGE(PG8_SB(1, 0), b3, voffB); PG8_STAGE(PG8_SB(1, 1), b3 + hstep, voffB); PG8_STAGE(PG8_SA(1, 0), a3, voffA);
            PG8_WAIT_V(8); PG8_WAIT_L(0); PG8_BAR; PG8_MMA(1, 0, At, B0); PG8_MMA(1, 1, At, B1); PG8_BAR; PG8_SCHED;
            } else {
            PG8_LDB(B0, 0, 0); PG8_SCHED; PG8_LDA(At, 0, 0); PG8_STAGE(PG8_SA(1, 1), a1 + hstep, voffA);
            PG8_WAIT_L(8); PG8_BAR; PG8_WAIT_L(0); PG8_MMA(0, 0, At, B0); PG8_BAR; PG8_SCHED;
            PG8_LDB(B1, 0, 1); PG8_STAGE(PG8_SB(0, 0), b2, voffB);
            PG8_BAR; PG8_WAIT_L(0); PG8_MMA(0, 1, At, B1); PG8_BAR;
            PG8_LDA(At, 0, 1); PG8_STAGE(PG8_SA(0, 0), a2, voffA);
            PG8_BAR; PG8_WAIT_L(0); PG8_MMA(1, 0, At, B0); PG8_BAR; PG8_SCHED;
            PG8_STAGE(PG8_SB(0, 1), b2 + hstep, voffB);
            PG8_WAIT_V(6); PG8_BAR; PG8_MMA(1, 1, At, B1); PG8_BAR;
            PG8_LDB(B0, 1, 0); PG8_SCHED; PG8_LDA(At, 1, 0); PG8_STAGE(PG8_SA(0, 1), a2 + hstep, voffA);
            PG8_WAIT_L(8); PG8_BAR; PG8_WAIT_L(0); PG8_MMA(0, 0, At, B0); PG8_BAR; PG8_SCHED;
            PG8_LDB(B1, 1, 1); PG8_STAGE(PG8_SB(1, 0), b3, voffB);
            PG8_BAR; PG8_WAIT_L(0); PG8_MMA(0, 1, At, B1); PG8_BAR;
            PG8_LDA(At, 1, 1); PG8_STAGE(PG8_SA(1, 0), a3, voffA);
            PG8_BAR; PG8_WAIT_L(0); PG8_MMA(1, 0, At, B0); PG8_BAR; PG8_SCHED;
            PG8_STAGE(PG8_SB(1, 1), b3 + hstep, voffB);
            PG8_WAIT_V(6); PG8_BAR; PG8_MMA(1, 1, At, B1); PG8_BAR;
            }
        }
        if constexpr (ALIGN_EPI) { if (wr == 0) PG8_BAR; }
        if constexpr (!Epi::AFTER_DRAIN) { E(acc, cur, wr, wc, fr, fq); S.done(cur); }
        if (!has_next) break;
#pragma unroll
        for (int a = 0; a < 2; ++a)
#pragma unroll
            for (int b = 0; b < 2; ++b)
#pragma unroll
                for (int m = 0; m < 4; ++m)
#pragma unroll
                    for (int n = 0; n < 2; ++n) acc[a][b][m][n] = (f32x4){0.f, 0.f, 0.f, 0.f};
        cur = nxt; cA = nA; cB = nB; ++ui;
        if constexpr (ALIGN_EPI) { if (wr == 1) PG8_BAR; }
    }
    PG8_WAIT_V(0);
    if constexpr (!ALIGN_EPI) { if (wr == 0) PG8_BAR; }
    PG8_BAR;
    if constexpr (Epi::AFTER_DRAIN) { E.fused(acc, cur, wr, wc, fr, fq, lds, wid, lane); S.done(cur); }
#undef PG8_SA
#undef PG8_SB
#undef PG8_STAGE
#undef PG8_LDA
#undef PG8_LDB
#undef PG8_MMA
#undef PG8_WAIT_V
#undef PG8_WAIT_L
#undef PG8_BAR
#undef PG8_SCHED
}
}

#define LAS __attribute__((address_space(3)))
typedef unsigned short bf16_t;
typedef short bf16x8 __attribute__((ext_vector_type(8)));
typedef float f32x4 __attribute__((ext_vector_type(4)));
typedef float f32x16 __attribute__((ext_vector_type(16)));
typedef unsigned u32x4 __attribute__((ext_vector_type(4)));
typedef unsigned u32x2 __attribute__((ext_vector_type(2)));
typedef _Float16 h16x2 __attribute__((ext_vector_type(2)));
typedef float cf2 __attribute__((ext_vector_type(2)));
__device__ __forceinline__ cf2 MKCF(float x, float y) { cf2 r; r.x = x; r.y = y; return r; }

constexpr int NB = 4, SEQ = 8192, DM = 1024, LC = 256;
constexpr int ML = NB * SEQ, MC = NB * LC, MT = ML + MC;
constexpr int NKEY = SEQ + LC;
constexpr int NTHR = 512;
constexpr int LDS_BYTES = 147456, LDS_BARST = 147200;
constexpr size_t MiB = 1u << 20;
constexpr size_t WS_BIG = 0, WS_ACT = 264 * MiB, WS_HCTX = 347 * MiB, WS_WB = 351 * MiB, WS_MODS = 446 * MiB, WS_H2 = 447 * MiB, WS_WSC = 452 * MiB, WS_BAR = 455 * MiB, WS_END = 456 * MiB;
constexpr size_t BIG_U = 0, BIG_Q = 99 * MiB, BIG_K = 132 * MiB, BIG_VT = 165 * MiB, BIG_KH = 198 * MiB;
constexpr size_t WB_W1 = 0, WB_W2 = WB_W1 + 4ull * 4096 * 1024, WB_EVIN = WB_W2 + 4ull * 4096 * 1024, WB_EVOUT = WB_EVIN + 2ull * 3072 * 1024,
                 WB_ODIN = WB_EVOUT + 2ull * 1024 * 1024, WB_ODOUT = WB_ODIN + 2ull * 2560 * 1024, WB_ENDE = WB_ODOUT + 2ull * 1024 * 1280;
static_assert(WB_ENDE * 2 <= 95 * MiB, "weights");
constexpr int NCH = 132;

__device__ __forceinline__ unsigned f2bf(float f) { unsigned u = __builtin_bit_cast(unsigned, f); return (u + 0x7fffu + ((u >> 16) & 1u)) >> 16; }
__device__ __forceinline__ unsigned pk2(float lo, float hi) { unsigned r; asm("v_cvt_pk_bf16_f32 %0, %1, %2" : "=v"(r) : "v"(lo), "v"(hi)); return r; }
__device__ __forceinline__ float bf2f(bf16_t h) { return __builtin_bit_cast(float, (unsigned)h << 16); }
__device__ __forceinline__ float shflx(float v, int m, int lane) { return __builtin_bit_cast(float, __builtin_amdgcn_ds_bpermute((lane ^ m) << 2, __builtin_bit_cast(int, v))); }
__device__ __forceinline__ float wave_sum(float v, int lane) {
#pragma unroll
    for (int o = 1; o < 64; o <<= 1) v += shflx(v, o, lane);
    return v;
}
__device__ __forceinline__ float sin_rev(float r) { return __builtin_amdgcn_sinf(r); }
__device__ __forceinline__ float cos_rev(float r) { return __builtin_amdgcn_cosf(r); }
__device__ __forceinline__ float fsin(float x) { float r = x * 0.15915494309189535f; r = r - floorf(r); return __builtin_amdgcn_sinf(r); }
__device__ __forceinline__ float fcos(float x) { float r = x * 0.15915494309189535f; r = r - floorf(r); return __builtin_amdgcn_cosf(r); }
__device__ __forceinline__ float sigmoidf_(float x) { return 1.0f / (1.0f + __expf(-x)); }
__device__ __forceinline__ float gelu_tanh(float g) { const float u = 0.7978845608028654f * (g + 0.044715f * g * g * g); const float t = 1.0f - 2.0f / (1.0f + __expf(2.0f * u)); return 0.5f * g * (1.0f + t); }

struct EpiStore {
    static constexpr bool PERM = true, AFTER_DRAIN = false;
    bf16_t* O; int ldc; int act;
    __device__ __forceinline__ void operator()(const f32x4 (&acc)[2][2][4][2], const pg8::Unit& u, int wr, int wc, int fr_, int fq_) const {
        int fr = fr_, fq = fq_; asm volatile("" : "+v"(fr), "+v"(fq));
        const int row0 = u.pm * 256 + wr * 64 + fr, col0 = u.pn * 256 + wc * 32 + 8 * fq;
#pragma unroll
        for (int ai = 0; ai < 2; ++ai)
#pragma unroll
            for (int m = 0; m < 4; ++m) {
                bf16_t* rowp = O + (size_t)(row0 + ai * 128 + m * 16) * ldc + col0;
#pragma unroll
                for (int bj = 0; bj < 2; ++bj) {
                    f32x4 v0 = acc[ai][bj][m][0], v1 = acc[ai][bj][m][1];
                    if (act) {
#pragma unroll
                        for (int x = 0; x < 4; ++x) { float a = fmaxf(v0[x], 0.f), b = fmaxf(v1[x], 0.f); v0[x] = a * a; v1[x] = b * b; }
                    }
                    u32x4 w; w.x = pk2(v0[0], v0[1]); w.y = pk2(v0[2], v0[3]); w.z = pk2(v1[0], v1[1]); w.w = pk2(v1[2], v1[3]);
                    *(u32x4*)(rowp + bj * 128) = w;
                }
            }
    }
};

struct EpiResid {
    static constexpr bool PERM = true, AFTER_DRAIN = false;
    const float* srcLat; const float* srcCtx; bf16_t* HLat; bf16_t* HCtx; const float* mods; int gateOff;
    __device__ __forceinline__ void operator()(const f32x4 (&acc)[2][2][4][2], const pg8::Unit& u, int wr, int wc, int fr_, int fq_) const {
        int fr = fr_, fq = fq_; asm volatile("" : "+v"(fr), "+v"(fq));
        const int row0 = u.pm * 256 + wr * 64 + fr, col0 = u.pn * 256 + wc * 32 + 8 * fq;
        const int rowt = u.pm * 256;
        const float* gp = mods + (rowt < ML ? (rowt >> 13) : 4) * 6144 + gateOff + col0;
        f32x4 g[2][2];
#pragma unroll
        for (int bj = 0; bj < 2; ++bj) { g[bj][0] = *(const f32x4*)(gp + bj * 128); g[bj][1] = *(const f32x4*)(gp + bj * 128 + 4); }
        const bool f32src = srcLat != nullptr;
#pragma unroll
        for (int ai = 0; ai < 2; ++ai)
#pragma unroll
            for (int m = 0; m < 4; ++m) {
                const int row = row0 + ai * 128 + m * 16;
                const size_t off = (row < ML) ? (size_t)row * 1024 + col0 : (size_t)(row - ML) * 1024 + col0;
                bf16_t* dp = ((row < ML) ? HLat : HCtx) + off;
#pragma unroll
                for (int bj = 0; bj < 2; ++bj) {
                    f32x4 s0, s1;
                    if (f32src) { const float* sp = ((row < ML) ? srcLat : srcCtx) + off + bj * 128; s0 = *(const f32x4*)sp; s1 = *(const f32x4*)(sp + 4); }
                    else { const u32x4 w = *(const u32x4*)(dp + bj * 128);
                        s0.x = __builtin_bit_cast(float, w.x << 16); s0.y = __builtin_bit_cast(float, w.x & 0xffff0000u); s0.z = __builtin_bit_cast(float, w.y << 16); s0.w = __builtin_bit_cast(float, w.y & 0xffff0000u);
                        s1.x = __builtin_bit_cast(float, w.z << 16); s1.y = __builtin_bit_cast(float, w.z & 0xffff0000u); s1.z = __builtin_bit_cast(float, w.w << 16); s1.w = __builtin_bit_cast(float, w.w & 0xffff0000u); }
                    const f32x4 o0 = s0 + g[bj][0] * acc[ai][bj][m][0], o1 = s1 + g[bj][1] * acc[ai][bj][m][1];
                    u32x4 ow; ow.x = pk2(o0.x, o0.y); ow.y = pk2(o0.z, o0.w); ow.z = pk2(o1.x, o1.y); ow.w = pk2(o1.z, o1.w);
                    *(u32x4*)(dp + bj * 128) = ow;
                }
            }
    }
};

struct EpiEvenIn {
    static constexpr bool PERM = true, AFTER_DRAIN = false;
    bf16_t *U, *Q, *K, *VT;
    __device__ __forceinline__ void operator()(const f32x4 (&acc)[2][2][4][2], const pg8::Unit& u, int wr, int wc, int fr_, int fq_) const {
        int fr = fr_, fq = fq_; asm volatile("" : "+v"(fr), "+v"(fq));
        const int row0 = u.pm * 256 + wr * 64 + fr;
        const int pn = u.pn;
        if (pn < 6) {
            const int col0 = pn * 256 + wc * 32 + 8 * fq;
#pragma unroll
            for (int ai = 0; ai < 2; ++ai)
#pragma unroll
                for (int m = 0; m < 4; ++m) {
                    const int row = row0 + ai * 128 + m * 16;
                    bf16_t* base; size_t cs;
                    if (row < ML) { base = U + (size_t)(row >> 13) * 1536 * 8192 + (row & 8191); cs = 8192; }
                    else { const int rr = row - ML; base = U + (size_t)4 * 1536 * 8192 + (size_t)(rr >> 8) * 1536 * 256 + (rr & 255); cs = 256; }
#pragma unroll
                    for (int bj = 0; bj < 2; ++bj) {
                        bf16_t* cpn = base + (size_t)(col0 + bj * 128) * cs;
                        const f32x4 v0 = acc[ai][bj][m][0], v1 = acc[ai][bj][m][1];
                        const unsigned w0 = pk2(v0[0], v0[1]), w1 = pk2(v0[2], v0[3]), w2 = pk2(v1[0], v1[1]), w3 = pk2(v1[2], v1[3]);
                        cpn[0] = (bf16_t)w0; cpn[cs] = (bf16_t)(w0 >> 16); cpn[2 * cs] = (bf16_t)w1; cpn[3 * cs] = (bf16_t)(w1 >> 16);
                        cpn[4 * cs] = (bf16_t)w2; cpn[5 * cs] = (bf16_t)(w2 >> 16); cpn[6 * cs] = (bf16_t)w3; cpn[7 * cs] = (bf16_t)(w3 >> 16);
                    }
                }
        } else if (pn < 10) {
            const bool isq = pn < 8;
            bf16_t* O = isq ? Q : K;
            const int col0 = ((pn - 6) & 1) * 256 + wc * 32 + 8 * fq;
            const float osc = isq ? 0.18033688011112042f : 1.0f;
            const bool lat = (u.pm * 256) < ML;
            const float fbase = -(float)(8 * (fq & 1)) * 0.8304820237218406f;
            const float sgn = (fq < 2) ? -1.0f : 1.0f;
#pragma unroll
            for (int ai = 0; ai < 2; ++ai)
#pragma unroll
                for (int m = 0; m < 4; ++m) {
                    const int row = row0 + ai * 128 + m * 16;
                    const int t = row & 8191;
                    const float pos = (float)((wc & 1) ? (t & 63) : (t >> 6));
                    bf16_t* rowp = O + (size_t)row * 512 + col0;
                    float o0[8], o1[8];
#pragma unroll
                    for (int e = 0; e < 8; ++e) {
                        float rv = pos * (__builtin_amdgcn_exp2f(fbase - (float)e * 0.8304820237218406f) * 0.15915494309189535f); rv = rv - floorf(rv);
                        const float cs = lat ? cos_rev(rv) : 1.0f, sn = (lat ? sin_rev(rv) : 0.0f) * sgn;
                        const float va = acc[ai][0][m][e >> 2][e & 3], vb = acc[ai][1][m][e >> 2][e & 3];
                        const float pa = shflx(va, 32, fq * 16 + fr), pb = shflx(vb, 32, fq * 16 + fr);
                        o0[e] = (va * cs + pa * sn) * osc; o1[e] = (vb * cs + pb * sn) * osc;
                    }
                    { u32x4 w; w.x = pk2(o0[0], o0[1]); w.y = pk2(o0[2], o0[3]); w.z = pk2(o0[4], o0[5]); w.w = pk2(o0[6], o0[7]); *(u32x4*)(rowp) = w; }
                    { u32x4 w; w.x = pk2(o1[0], o1[1]); w.y = pk2(o1[2], o1[3]); w.z = pk2(o1[4], o1[5]); w.w = pk2(o1[6], o1[7]); *(u32x4*)(rowp + 128) = w; }
                }
        } else {
#pragma unroll
            for (int ai = 0; ai < 2; ++ai)
#pragma unroll
                for (int m = 0; m < 4; ++m) {
                    const int row = row0 + ai * 128 + m * 16;
                    int b, key;
                    if (row < ML) { b = row >> 13; key = row & 8191; } else { const int rr = row - ML; b = rr >> 8; key = 8192 + (rr & 255); }
#pragma unroll
                    for (int bj = 0; bj < 2; ++bj) {
                        const int hh = (pn - 10) * 2 + bj;
                        bf16_t* vp = VT + ((size_t)(b * 4 + hh) * 128 + wc * 32 + 8 * fq) * NKEY + key;
#pragma unroll
                        for (int x = 0; x < 4; ++x) { vp[(size_t)x * NKEY] = (bf16_t)f2bf(acc[ai][bj][m][0][x]); vp[(size_t)(4 + x) * NKEY] = (bf16_t)f2bf(acc[ai][bj][m][1][x]); }
                    }
                }
        }
    }
};

__device__ __forceinline__ void load_row16(const float* f32p, const bf16_t* b16p, int lane, float (&v)[16]) {
    if (f32p) {
#pragma unroll
        for (int j = 0; j < 2; ++j) { const f32x4 a0 = *(const f32x4*)(f32p + 8 * lane + 512 * j), a1 = *(const f32x4*)(f32p + 8 * lane + 512 * j + 4);
            v[8 * j] = a0.x; v[8 * j + 1] = a0.y; v[8 * j + 2] = a0.z; v[8 * j + 3] = a0.w; v[8 * j + 4] = a1.x; v[8 * j + 5] = a1.y; v[8 * j + 6] = a1.z; v[8 * j + 7] = a1.w; }
    } else {
#pragma unroll
        for (int j = 0; j < 2; ++j) { const u32x4 w = *(const u32x4*)(b16p + 8 * lane + 512 * j);
            v[8 * j] = __builtin_bit_cast(float, w.x << 16); v[8 * j + 1] = __builtin_bit_cast(float, w.x & 0xffff0000u); v[8 * j + 2] = __builtin_bit_cast(float, w.y << 16); v[8 * j + 3] = __builtin_bit_cast(float, w.y & 0xffff0000u);
            v[8 * j + 4] = __builtin_bit_cast(float, w.z << 16); v[8 * j + 5] = __builtin_bit_cast(float, w.z & 0xffff0000u); v[8 * j + 6] = __builtin_bit_cast(float, w.w << 16); v[8 * j + 7] = __builtin_bit_cast(float, w.w & 0xffff0000u); }
    }
}
__device__ __forceinline__ void norm_rows(const float* srcLat, const float* srcCtx, const bf16_t* HLat, const bf16_t* HCtx, const float* g, const float* mods, int shOff, int scOff, bf16_t* A, int nrows, int gw, int ngw, int lane) {
    for (int row = gw; row < nrows; row += ngw) {
        const float* md = mods + (row < ML ? (row >> 13) : 4) * 6144;
        const size_t off = (row < ML) ? (size_t)row * 1024 : (size_t)(row - ML) * 1024;
        float v[16];
        load_row16(srcLat ? ((row < ML) ? srcLat : srcCtx) + off : nullptr, ((row < ML) ? HLat : HCtx) + off, lane, v);
        float ss = 0.f;
#pragma unroll
        for (int e = 0; e < 16; ++e) ss += v[e] * v[e];
        ss = wave_sum(ss, lane);
        const float rstd = rsqrtf(ss * (1.0f / 1024.0f) + 1e-6f);
#pragma unroll
        for (int j = 0; j < 2; ++j) {
            const int k = 8 * lane + 512 * j;
            float y[8];
#pragma unroll
            for (int hq = 0; hq < 2; ++hq) {
                const f32x4 gg = *(const f32x4*)(g + k + 4 * hq), sc = *(const f32x4*)(md + scOff + k + 4 * hq), sh = *(const f32x4*)(md + shOff + k + 4 * hq);
                y[4 * hq] = v[8 * j + 4 * hq] * rstd * gg.x * (sc.x + 1.0f) + sh.x; y[4 * hq + 1] = v[8 * j + 4 * hq + 1] * rstd * gg.y * (sc.y + 1.0f) + sh.y;
                y[4 * hq + 2] = v[8 * j + 4 * hq + 2] * rstd * gg.z * (sc.z + 1.0f) + sh.z; y[4 * hq + 3] = v[8 * j + 4 * hq + 3] * rstd * gg.w * (sc.w + 1.0f) + sh.w;
            }
            u32x4 w; w.x = pk2(y[0], y[1]); w.y = pk2(y[2], y[3]); w.z = pk2(y[4], y[5]); w.w = pk2(y[6], y[7]);
            *(u32x4*)(A + (size_t)row * 1024 + k) = w;
        }
    }
}
__device__ __forceinline__ void final_norm(const bf16_t* H16, float* out, float* tmp, const float* g, int gw, int ngw, int lane) {
    for (int row = gw; row < ML; row += ngw) {
        float v[16];
        load_row16(nullptr, H16 + (size_t)row * 1024, lane, v);
        float ss = 0.f;
#pragma unroll
        for (int e = 0; e < 16; ++e) ss += v[e] * v[e];
        ss = wave_sum(ss, lane);
        const float rstd = rsqrtf(ss * (1.0f / 1024.0f) + 1e-6f);
        float* dst = (row < 16384) ? out + (size_t)row * 1024 : tmp + (size_t)(row - 16384) * 1024;
#pragma unroll
        for (int j = 0; j < 2; ++j)
#pragma unroll
            for (int hq = 0; hq < 2; ++hq) {
                const int k = 8 * lane + 512 * j + 4 * hq; const f32x4 gg = *(const f32x4*)(g + k);
                f32x4 y; y.x = v[8 * j + 4 * hq] * rstd * gg.x; y.y = v[8 * j + 4 * hq + 1] * rstd * gg.y; y.z = v[8 * j + 4 * hq + 2] * rstd * gg.z; y.w = v[8 * j + 4 * hq + 3] * rstd * gg.w;
                *(f32x4*)(dst + k) = y;
            }
    }
}
__device__ __forceinline__ void final_copy(const float* tmp, float* out_hi, int gtid, int nthr) {
    const f32x4* s = (const f32x4*)tmp; f32x4* d = (f32x4*)out_hi;
    for (int i = gtid; i < 16384 * 256; i += nthr) d[i] = s[i];
}

__device__ __forceinline__ void transpose_item(const float* W, int K, int N, bf16_t* WT, LAS float* scr, int item, int lane) {
    const int nblk = N / 32, kb = item / nblk, nb = item % nblk, k0 = 64 * kb, n0 = 32 * nb;
#pragma unroll 8
    for (int i = 0; i < 32; ++i) { const int kk = 2 * i + (lane >> 5); scr[kk * 33 + (lane & 31)] = W[(size_t)(k0 + kk) * N + n0 + (lane & 31)]; }
    asm volatile("s_waitcnt lgkmcnt(0)" ::: "memory");
    const int c = lane & 7;
#pragma unroll
    for (int j = 0; j < 4; ++j) {
        const int n = (lane >> 3) + 8 * j; const LAS float* s = scr + (8 * c) * 33 + n;
        u32x4 o; o.x = pk2(s[0 * 33], s[1 * 33]); o.y = pk2(s[2 * 33], s[3 * 33]); o.z = pk2(s[4 * 33], s[5 * 33]); o.w = pk2(s[6 * 33], s[7 * 33]);
        *(u32x4*)(WT + (size_t)(n0 + n) * K + k0 + 8 * c) = o;
    }
    asm volatile("s_waitcnt lgkmcnt(0)" ::: "memory");
}
#define XB_TMO      128
#define XB_XCNT(j)  (256  + 64 * (j))
#define XB_XSUB(j)  (1280 + 64 * (j))
#define XB_XGEN(j)  (2304 + 64 * (j))
#define XB_TOP      3328
#define XB_TOPGEN   3392
#define XCD_BAR_WORDS 3456
#define XB_SPIN_CAP (1u << 18)

__device__ __forceinline__ unsigned xb_ld(unsigned* p)              { return __hip_atomic_load(p, __ATOMIC_RELAXED, __HIP_MEMORY_SCOPE_AGENT); }
__device__ __forceinline__ unsigned xb_add(unsigned* p, unsigned v) { return __hip_atomic_fetch_add(p, v, __ATOMIC_RELAXED, __HIP_MEMORY_SCOPE_AGENT); }
__device__ __forceinline__ unsigned xb_xcc_id() { return (unsigned)__builtin_amdgcn_s_getreg((3 << 11) | 20) & 0xFu; }
#define XB_SPIN(cond, bar) do { unsigned _sp = 0; while (cond) { __builtin_amdgcn_s_sleep(1); \
    if ((++_sp & 255u) == 0u) { if (xb_ld(&(bar)[XB_TMO])) break; if (_sp > XB_SPIN_CAP) { atomicAdd(&(bar)[XB_TMO], 1u); break; } } } } while (0)

struct XcdBarrier {
    unsigned* bar; unsigned x;
    volatile LAS unsigned* st;
};

__device__ __forceinline__ XcdBarrier xcd_barrier_post(unsigned* bar, volatile LAS unsigned* st) {
    XcdBarrier b; b.bar = bar; b.x = xb_xcc_id(); b.st = st;
    if (threadIdx.x == 0) (void)xb_add(&bar[XB_XCNT(b.x)], 1u);
    return b;
}
__device__ __forceinline__ void xcd_barrier_complete(unsigned* bar, unsigned x, unsigned& nloc, unsigned& nx) {
    const unsigned G = gridDim.x * gridDim.y * gridDim.z;
    unsigned sum, cnt, mine, sp = 0u;
    for (;;) {
        sum = 0u; cnt = 0u; mine = 0u;
#pragma unroll 1
        for (unsigned j = 0; j < 16; ++j) { const unsigned c = xb_ld(&bar[XB_XCNT(j)]); sum += c; cnt += (c > 0u) ? 1u : 0u; mine = (j == x) ? c : mine; }
        if (sum == G) break;
        __builtin_amdgcn_s_sleep(1);
        if ((++sp & 255u) == 0u) { if (xb_ld(&bar[XB_TMO])) break; if (sp > XB_SPIN_CAP) { atomicAdd(&bar[XB_TMO], 1u); break; } }
    }
    nloc = mine > 0u ? mine : 1u; nx = cnt > 0u ? cnt : 1u;
}

__device__ __forceinline__ void xcd_barrier(const XcdBarrier& b) {
    asm volatile("s_waitcnt vmcnt(0)" ::: "memory");
    __syncthreads();
    if (threadIdx.x == 0) {
        unsigned* bar = b.bar;
        __builtin_amdgcn_s_waitcnt(0);
        unsigned nloc = b.st[0], nx = b.st[1];
        if (nloc == 0u) { xcd_barrier_complete(bar, b.x, nloc, nx); b.st[0] = nloc; b.st[1] = nx; }
        const unsigned old = xb_add(&bar[XB_XSUB(b.x)], 1u);
        const unsigned gen = old / nloc;
        if (old + 1u == (gen + 1u) * nloc) {
            __builtin_amdgcn_fence(__ATOMIC_RELEASE, "agent");
            asm volatile("s_waitcnt vmcnt(0)" ::: "memory");
            const unsigned og = xb_add(&bar[XB_TOP], 1u);
            const unsigned tg = og / nx;
            if (og + 1u == (tg + 1u) * nx) xb_add(&bar[XB_TOPGEN], 1u);
            else XB_SPIN(xb_ld(&bar[XB_TOPGEN]) == tg, bar);
            __builtin_amdgcn_fence(__ATOMIC_ACQUIRE, "agent");
            xb_add(&bar[XB_XGEN(b.x)], 1u);
            asm volatile("s_waitcnt vmcnt(0)" ::: "memory");
        } else {
            XB_SPIN(xb_ld(&bar[XB_XGEN(b.x)]) == gen, bar);
            __builtin_amdgcn_fence(__ATOMIC_ACQUIRE, "agent");
            asm volatile("s_waitcnt vmcnt(0)" ::: "memory");
        }
    }
    __syncthreads();
}

struct KArgs { const float* in[38]; float* out; unsigned char* ws; int ph_lo, ph_hi; };
typedef const __attribute__((address_space(4))) KArgs& KArgsR;
typedef const __attribute__((address_space(4))) KArgs* KArgsP;
__device__ __forceinline__ KArgsP opaque_kargs(KArgsP p) {
    const unsigned long long v = (unsigned long long)p; unsigned lo = (unsigned)v, hi = (unsigned)(v >> 32);
    asm volatile("" : "+s"(lo), "+s"(hi));
    lo = __builtin_amdgcn_readfirstlane(lo); hi = __builtin_amdgcn_readfirstlane(hi);
    return (KArgsP)(((unsigned long long)hi << 32) | lo);
}

__device__ __forceinline__ void p0_phase(KArgsR a, LAS unsigned char* lds, int tid, int lane, int wid) {
    const int G = gridDim.x, bid = blockIdx.x;
    const int gw = bid * 8 + wid, ngw = G * 8;
    {
        LAS float* sl = (LAS float*)(lds + 69632);
        LAS float* red = (LAS float*)(lds + 90112);
        const float* c = a.in[1]; const float* cctx = a.in[3]; const float* ada_w = a.in[4]; const float* ada_b = a.in[5];
        float* MODS = (float*)(a.ws + WS_MODS);
        for (int idx = tid; idx < 5 * 1024; idx += NTHR) { const int s = idx >> 10, k = idx & 1023; const float x = s < 4 ? c[s * 1024 + k] : cctx[k]; sl[idx] = x / (1.0f + __expf(-x)); }
        __syncthreads();
        for (int item = bid; item < 384; item += G) {
            const int i = item / 96, cgp = item % 96;
            const float* W = ada_w + (size_t)i * 1024 * 6144 + cgp * 64 + lane;
            float acc[5] = {0.f, 0.f, 0.f, 0.f, 0.f};
            const int k0 = wid * 128;
#pragma unroll 8
            for (int kk = 0; kk < 128; ++kk) {
                const float w = W[(size_t)(k0 + kk) * 6144];
#pragma unroll
                for (int s = 0; s < 5; ++s) acc[s] += sl[s * 1024 + k0 + kk] * w;
            }
#pragma unroll
            for (int s = 0; s < 5; ++s) red[(wid * 5 + s) * 64 + lane] = acc[s];
            __syncthreads();
            if (tid < 320) {
                const int s = tid >> 6, l = tid & 63; float sum = ada_b[i * 6144 + cgp * 64 + l];
#pragma unroll
                for (int w = 0; w < 8; ++w) sum += red[(w * 5 + s) * 64 + l];
                MODS[(size_t)(i * 5 + s) * 6144 + cgp * 64 + l] = sum;
            }
            __syncthreads();
        }
    }
    {
        LAS float* scr = (LAS float*)(lds + wid * 8448);
        bf16_t* WB = (bf16_t*)(a.ws + WS_WB);
        for (int mi = 0; mi < 16; ++mi) {
            const float* W; int K, N; bf16_t* WT;
            if (mi < 4)       { W = a.in[8]  + (size_t)mi * 1024 * 4096;        K = 1024; N = 4096; WT = WB + WB_W1 + (size_t)mi * 4096 * 1024; }
            else if (mi < 8)  { W = a.in[9]  + (size_t)(mi - 4) * 4096 * 1024;  K = 4096; N = 1024; WT = WB + WB_W2 + (size_t)(mi - 4) * 4096 * 1024; }
            else if (mi < 10) { W = a.in[11] + (size_t)(mi - 8) * 1024 * 3072;  K = 1024; N = 3072; WT = WB + WB_EVIN + (size_t)(mi - 8) * 3072 * 1024; }
            else if (mi < 12) { W = a.in[12] + (size_t)(mi - 10) * 1024 * 1024; K = 1024; N = 1024; WT = WB + WB_EVOUT + (size_t)(mi - 10) * 1024 * 1024; }
            else if (mi < 14) { W = a.in[29] + (size_t)(mi - 12) * 1024 * 2560; K = 1024; N = 2560; WT = WB + WB_ODIN + (size_t)(mi - 12) * 2560 * 1024; }
            else              { W = a.in[30] + (size_t)(mi - 14) * 1280 * 1024; K = 1280; N = 1024; WT = WB + WB_ODOUT + (size_t)(mi - 14) * 1024 * 1280; }
            const int nit = (K / 64) * (N / 32);
            for (int it = gw; it < nit; it += ngw) transpose_item(W, K, N, WT, scr, it, lane);
        }
    }
    {
        bf16_t* WSC = (bf16_t*)(a.ws + WS_WSC);
        for (int it = bid; it < 128; it += G) {
            const int mat = it & 1, jdn = it >> 1;
            const float* W = (mat ? a.in[35] : a.in[33]) + (size_t)jdn * 6400;
            bf16_t* O = WSC + (size_t)it * 7680;
            for (int idx = tid; idx < 7680; idx += NTHR) { const int dp = idx / 96, c = idx % 96; O[idx] = (bf16_t)f2bf(c < 80 ? W[c * 80 + dp] : 0.f); }
        }
    }
    {
        _Float16* H2 = (_Float16*)(a.ws + WS_H2);
        for (int rowi = gw; rowi < 2 * 8448; rowi += ngw) {
            const int j = rowi / 8448, p = rowi % 8448;
            const float* w1 = a.in[15] + j * 33 * 64; const float* b1 = a.in[16] + j * 64; const float* w2 = a.in[17] + j * 64 * 64; const float* b2 = a.in[18] + j * 64;
            const float fq = a.in[21][j * 64 + lane];
            int pp, L; if (p < 8192) { pp = p; L = 8192; } else { pp = p - 8192; L = 256; }
            const float invL = 1.0f / (float)L;
            const float t = (float)pp * invL;
            float z = b1[lane] + t * w1[lane];
#pragma unroll 4
            for (int n = 1; n <= 16; ++n) {
                const float rv = (float)((pp * n) & (L - 1)) * invL;
                z += cos_rev(rv) * w1[n * 64 + lane] + sin_rev(rv) * w1[(16 + n) * 64 + lane];
            }
            const float h1 = fsin(fq * z);
            float z2 = b2[lane];
#pragma unroll 8
            for (int k = 0; k < 64; ++k) z2 += __builtin_bit_cast(float, __builtin_amdgcn_readlane(__builtin_bit_cast(int, h1), k)) * w2[k * 64 + lane];
            H2[(size_t)rowi * 64 + lane] = (_Float16)fsin(fq * z2);
        }
    }
}

__device__ __forceinline__ cf2 cmul(cf2 a, cf2 b) { return MKCF(a.x * b.x - a.y * b.y, a.x * b.y + a.y * b.x); }
template <bool UZ> __device__ __forceinline__ void fft_fwd_t(LAS cf2* X, int tid) {
#pragma unroll 1
    for (int s = 0; s < 7; ++s) {
        const int lq = 12 - 2 * s, q = 1 << lq;
        const float rs = __builtin_bit_cast(float, (unsigned)(127 - (lq + 2)) << 23);
        if (lq > 9) {
#pragma unroll 2
            for (int i = 0; i < 8; ++i) {
                const int bf = tid + NTHR * i, j = bf & (q - 1), i0 = ((bf >> lq) << (lq + 2)) + j;
                const bool z = UZ && (s == 0);
                const cf2 x0 = X[i0], x1 = X[i0 + q], x2 = z ? MKCF(0.f, 0.f) : X[i0 + 2 * q], x3 = z ? MKCF(0.f, 0.f) : X[i0 + 3 * q];
                const float rv = (float)j * rs;
                const cf2 w1 = MKCF(cos_rev(rv), -sin_rev(rv)), w2 = cmul(w1, w1), w3 = cmul(w2, w1);
                const cf2 A = MKCF(x0.x + x2.x, x0.y + x2.y), B = MKCF(x0.x - x2.x, x0.y - x2.y), C = MKCF(x1.x + x3.x, x1.y + x3.y), D = MKCF(x1.x - x3.x, x1.y - x3.y);
                X[i0] = MKCF(A.x + C.x, A.y + C.y);
                X[i0 + q] = cmul(MKCF(B.x + D.y, B.y - D.x), w1);
                X[i0 + 2 * q] = cmul(MKCF(A.x - C.x, A.y - C.y), w2);
                X[i0 + 3 * q] = cmul(MKCF(B.x - D.y, B.y + D.x), w3);
            }
        } else {
            const int j = tid & (q - 1);
            const float rv = (float)j * rs;
            const cf2 w1 = MKCF(cos_rev(rv), -sin_rev(rv)), w2 = cmul(w1, w1), w3 = cmul(w2, w1);
#pragma unroll 4
            for (int i = 0; i < 8; ++i) {
                const int bf = tid + NTHR * i, i0 = ((bf >> lq) << (lq + 2)) + j;
                const cf2 x0 = X[i0], x1 = X[i0 + q], x2 = X[i0 + 2 * q], x3 = X[i0 + 3 * q];
                const cf2 A = MKCF(x0.x + x2.x, x0.y + x2.y), B = MKCF(x0.x - x2.x, x0.y - x2.y), C = MKCF(x1.x + x3.x, x1.y + x3.y), D = MKCF(x1.x - x3.x, x1.y - x3.y);
                X[i0] = MKCF(A.x + C.x, A.y + C.y);
                X[i0 + q] = cmul(MKCF(B.x + D.y, B.y - D.x), w1);
                X[i0 + 2 * q] = cmul(MKCF(A.x - C.x, A.y - C.y), w2);
                X[i0 + 3 * q] = cmul(MKCF(B.x - D.y, B.y + D.x), w3);
            }
        }
        __syncthreads();
    }
}
__device__ __forceinline__ void fft_fwd(LAS cf2* X, int tid) { fft_fwd_t<false>(X, tid); }
template <bool LH> __device__ __forceinline__ void fft_inv_t(LAS cf2* X, int tid) {
#pragma unroll 1
    for (int s = 6; s >= 0; --s) {
        const int lq = 12 - 2 * s, q = 1 << lq;
        const float rs = __builtin_bit_cast(float, (unsigned)(127 - (lq + 2)) << 23);
        if (lq > 9) {
#pragma unroll 2
            for (int i = 0; i < 8; ++i) {
                const int bf = tid + NTHR * i, j = bf & (q - 1), i0 = ((bf >> lq) << (lq + 2)) + j;
                const float rv = (float)j * rs;
                const cf2 w1 = MKCF(cos_rev(rv), sin_rev(rv)), w2 = cmul(w1, w1), w3 = cmul(w2, w1);
                const cf2 u0 = X[i0], u1 = cmul(X[i0 + q], w1), u2 = cmul(X[i0 + 2 * q], w2), u3 = cmul(X[i0 + 3 * q], w3);
                const cf2 A = MKCF(u0.x + u2.x, u0.y + u2.y), B = MKCF(u0.x - u2.x, u0.y - u2.y), C = MKCF(u1.x + u3.x, u1.y + u3.y), D = MKCF(u1.x - u3.x, u1.y - u3.y);
                X[i0] = MKCF(A.x + C.x, A.y + C.y);
                X[i0 + q] = MKCF(B.x - D.y, B.y + D.x);
                if (!(LH && s == 0)) {
                    X[i0 + 2 * q] = MKCF(A.x - C.x, A.y - C.y);
                    X[i0 + 3 * q] = MKCF(B.x + D.y, B.y - D.x);
                }
            }
        } else {
            const int j = tid & (q - 1);
            const float rv = (float)j * rs;
            const cf2 w1 = MKCF(cos_rev(rv), sin_rev(rv)), w2 = cmul(w1, w1), w3 = cmul(w2, w1);
#pragma unroll 4
            for (int i = 0; i < 8; ++i) {
                const int bf = tid + NTHR * i, i0 = ((bf >> lq) << (lq + 2)) + j;
                const cf2 u0 = X[i0], u1 = cmul(X[i0 + q], w1), u2 = cmul(X[i0 + 2 * q], w2), u3 = cmul(X[i0 + 3 * q], w3);
                const cf2 A = MKCF(u0.x + u2.x, u0.y + u2.y), B = MKCF(u0.x - u2.x, u0.y - u2.y), C = MKCF(u1.x + u3.x, u1.y + u3.y), D = MKCF(u1.x - u3.x, u1.y - u3.y);
                X[i0] = MKCF(A.x + C.x, A.y + C.y);
                X[i0 + q] = MKCF(B.x - D.y, B.y + D.x);
                X[i0 + 2 * q] = MKCF(A.x - C.x, A.y - C.y);
                X[i0 + 3 * q] = MKCF(B.x + D.y, B.y - D.x);
            }
        }
        __syncthreads();
    }
}
__device__ __forceinline__ void fft_inv(LAS cf2* X, int tid) { fft_inv_t<false>(X, tid); }
__device__ __forceinline__ void mul_spectrum(LAS cf2* X, const unsigned* KH, float bias, int tid) {
#pragma unroll 4
    for (int i = 0; i < 32; ++i) {
        const int p = tid + NTHR * i;
        const h16x2 kh = __builtin_bit_cast(h16x2, KH[p]);
        X[p] = cmul(X[p], MKCF((float)kh.x + bias, (float)kh.y));
    }
    __syncthreads();
}

typedef _Float16 f16x8 __attribute__((ext_vector_type(8)));
__device__ __forceinline__ int rev4_14(int x) { const unsigned r = __builtin_bitreverse32((unsigned)x) >> 18; return (int)(((r & 0x2AAAu) >> 1) | ((r & 0x1555u) << 1)); }
__device__ __forceinline__ void khat_item(KArgsR a, LAS unsigned char* lds, int j, int c, int tid) {
    LAS cf2* X = (LAS cf2*)lds; LAS float* Xf = (LAS float*)lds;
    const int lane = tid & 63, wid = tid >> 6, r = lane & 31, h = lane >> 5;
    const float* w3 = a.in[19] + (size_t)j * 64 * 2048; const float* b3 = a.in[20] + j * 2048; const float* decay = a.in[22] + (size_t)j * 2048;
    const _Float16* H2 = (const _Float16*)(a.ws + WS_H2) + (size_t)j * 8448 * 64;
    unsigned* KH = (unsigned*)(a.ws + WS_BIG + BIG_KH);
    const int o = (r >> 1) & 1, dir = r & 1;
    const int col = o * 1024 + dir * 512 + c;
    f16x8 bfr[4];
#pragma unroll
    for (int ks = 0; ks < 4; ++ks)
#pragma unroll
        for (int jj = 0; jj < 8; ++jj) bfr[ks][jj] = (r < 4) ? (_Float16)w3[(size_t)(16 * ks + 8 * h + jj) * 2048 + col] : (_Float16)0.f;
    const float bb = b3[col], dsc = fabsf(decay[col]) * (1.4426950408889634f / 8192.0f);
    if (tid == 0) X[8192] = MKCF(0.f, 0.f);
#pragma unroll 4
    for (int ti = 0; ti < 32; ++ti) {
        const int tl = wid + 8 * ti;
        f32x16 acc;
#pragma unroll
        for (int i = 0; i < 16; ++i) acc[i] = 0.f;
#pragma unroll
        for (int ks = 0; ks < 4; ++ks) {
            const f16x8 af = *(const f16x8*)(H2 + (size_t)(32 * tl + r) * 64 + 16 * ks + 8 * h);
            acc = __builtin_amdgcn_mfma_f32_32x32x16_f16(af, bfr[ks], acc, 0, 0, 0);
        }
        if (r < 4) {
#pragma unroll
            for (int i = 0; i < 16; ++i) {
                const int p = 32 * tl + (i & 3) + 8 * (i >> 2) + 4 * h;
                const float val = (acc[i] + bb) * __builtin_amdgcn_exp2f(-(float)p * dsc);
                if (dir == 0) Xf[2 * p + o] = val;
                else if (p != 0) Xf[2 * (16384 - p) + o] = val;
            }
        }
    }
    __syncthreads();
    fft_fwd(X, tid);
#pragma unroll 4
    for (int i = 0; i < 32; ++i) {
        const int p = tid + NTHR * i;
        const int k = rev4_14(p), pm = rev4_14((16384 - k) & 16383);
        const cf2 z = X[p], zm = X[pm];
        h16x2 k0, k1;
        k0.x = (_Float16)(0.5f * (z.x + zm.x)); k0.y = (_Float16)(0.5f * (z.y - zm.y));
        k1.x = (_Float16)(0.5f * (z.y + zm.y)); k1.y = (_Float16)(0.5f * (zm.x - z.x));
        KH[(size_t)c * 16384 + p] = __builtin_bit_cast(unsigned, k0);
        KH[(size_t)(512 + c) * 16384 + p] = __builtin_bit_cast(unsigned, k1);
    }
    __syncthreads();
}

__device__ __forceinline__ float conv3_at(const bf16_t* p, int t, float w0, float w1, float w2, float bs) {
    const float l = t > 0 ? bf2f(p[t - 1]) : 0.f, m = bf2f(p[t]), r = t < 8191 ? bf2f(p[t + 1]) : 0.f;
    return w0 * l + w1 * m + w2 * r + bs;
}
__device__ __forceinline__ void conv3_pair(const bf16_t* p, int t2, float w0, float w1, float w2, float bs, float (&o)[2]) {
    const unsigned wm = *(const unsigned*)(p + t2);
    const unsigned wl = t2 > 0 ? *(const unsigned*)(p + t2 - 2) : 0u, wr = t2 < 8190 ? *(const unsigned*)(p + t2 + 2) : 0u;
    const float xm1 = __builtin_bit_cast(float, wl & 0xffff0000u), x0 = __builtin_bit_cast(float, wm << 16), x1 = __builtin_bit_cast(float, wm & 0xffff0000u), x2 = __builtin_bit_cast(float, wr << 16);
    o[0] = w0 * xm1 + w1 * x0 + w2 * x1 + bs; o[1] = w0 * x0 + w1 * x1 + w2 * x2 + bs;
}
__device__ __forceinline__ void hyena_lat_item(KArgsR a, LAS unsigned char* lds, int j, int c, int pair, int tid) {
    LAS cf2* X = (LAS cf2*)lds;
    const bf16_t* UT = (const bf16_t*)(a.ws + WS_BIG + BIG_U);
    const unsigned* KH = (const unsigned*)(a.ws + WS_BIG + BIG_KH);
    bf16_t* ACT = (bf16_t*)(a.ws + WS_ACT);
    const float* sw = a.in[13] + (size_t)j * 3 * 1536; const float* sb = a.in[14] + j * 1536; const float* hbias = a.in[23] + j * 1024;
    const int b0 = 2 * pair;
    const bf16_t* V0 = UT + ((size_t)b0 * 1536 + c) * 8192; const bf16_t* V1 = V0 + (size_t)1536 * 8192;
    const float wv0 = sw[c], wv1 = sw[1536 + c], wv2 = sw[3072 + c], bv = sb[c];
    const float wa0 = sw[512 + c], wa1 = sw[1536 + 512 + c], wa2 = sw[3072 + 512 + c], ba_ = sb[512 + c];
    const float wb0 = sw[1024 + c], wb1 = sw[1536 + 1024 + c], wb2 = sw[3072 + 1024 + c], bb_ = sb[1024 + c];
    const float bias0 = hbias[c], bias1 = hbias[512 + c];
#pragma unroll 4
    for (int i = 0; i < 8; ++i) {
        const int t2 = 2 * tid + 1024 * i;
        const unsigned w0 = *(const unsigned*)(V0 + t2), w1 = *(const unsigned*)(V1 + t2);
        f32x4 o; o.x = __builtin_bit_cast(float, w0 << 16); o.y = __builtin_bit_cast(float, w1 << 16); o.z = __builtin_bit_cast(float, w0 & 0xffff0000u); o.w = __builtin_bit_cast(float, w1 & 0xffff0000u);
        *(LAS f32x4*)(X + t2) = o;
    }
    __syncthreads();
#pragma unroll 2
    for (int i = 0; i < 16; ++i) {
        const int t = tid + NTHR * i;
        const cf2 l = t > 0 ? X[t - 1] : MKCF(0.f, 0.f), m = X[t], r = t < 8191 ? X[t + 1] : MKCF(0.f, 0.f);
        X[8192 + t] = MKCF(wv0 * l.x + wv1 * m.x + wv2 * r.x + bv, wv0 * l.y + wv1 * m.y + wv2 * r.y + bv);
    }
    __syncthreads();
#pragma unroll 2
    for (int i = 0; i < 16; ++i) { const int t = tid + NTHR * i; X[t] = X[8192 + t]; }
    __syncthreads();
    fft_fwd_t<true>(X, tid);
    mul_spectrum(X, KH + (size_t)c * 16384, bias0, tid);
    fft_inv_t<true>(X, tid);
    {
        const bf16_t* A0 = V0 + (size_t)512 * 8192; const bf16_t* A1 = V1 + (size_t)512 * 8192;
#pragma unroll 2
        for (int i = 0; i < 8; ++i) {
            const int t2 = 2 * tid + 1024 * i;
            float xa[2], xb[2];
            conv3_pair(A0, t2, wa0, wa1, wa2, ba_, xa); conv3_pair(A1, t2, wa0, wa1, wa2, ba_, xb);
            const f32x4 y = *(const LAS f32x4*)(X + t2);
            f32x4 o; o.x = xa[0] * y.x * (1.0f / 16384.0f); o.y = xb[0] * y.y * (1.0f / 16384.0f); o.z = xa[1] * y.z * (1.0f / 16384.0f); o.w = xb[1] * y.w * (1.0f / 16384.0f);
            *(LAS f32x4*)(X + t2) = o;
        }
    }
    __syncthreads();
    fft_fwd_t<true>(X, tid);
    mul_spectrum(X, KH + (size_t)(512 + c) * 16384, bias1, tid);
    fft_inv_t<true>(X, tid);
    {
        const bf16_t* B0 = V0 + (size_t)1024 * 8192; const bf16_t* B1 = V1 + (size_t)1024 * 8192;
#pragma unroll 2
        for (int i = 0; i < 8; ++i) {
            const int t2 = 2 * tid + 1024 * i;
            float xa[2], xb[2];
            conv3_pair(B0, t2, wb0, wb1, wb2, bb_, xa); conv3_pair(B1, t2, wb0, wb1, wb2, bb_, xb);
            const f32x4 y = *(const LAS f32x4*)(X + t2);
            ACT[(size_t)(b0 * 8192 + t2) * 1024 + c] = (bf16_t)f2bf(xa[0] * y.x * (1.0f / 16384.0f));
            ACT[(size_t)((b0 + 1) * 8192 + t2) * 1024 + c] = (bf16_t)f2bf(xb[0] * y.y * (1.0f / 16384.0f));
            ACT[(size_t)(b0 * 8192 + t2 + 1) * 1024 + c] = (bf16_t)f2bf(xa[1] * y.z * (1.0f / 16384.0f));
            ACT[(size_t)((b0 + 1) * 8192 + t2 + 1) * 1024 + c] = (bf16_t)f2bf(xb[1] * y.w * (1.0f / 16384.0f));
        }
    }
    __syncthreads();
}

__device__ __forceinline__ void hyena_ctx_item(KArgsR a, LAS unsigned char* lds, int j, int c, int tid) {
    LAS float* ks = (LAS float*)lds;
    LAS float* vc = ks + 1024;
    LAS float* zc = vc + 1024;
    LAS float* w3c = zc + 1024;
    const bf16_t* U = (const bf16_t*)(a.ws + WS_BIG + BIG_U);
    bf16_t* ACT = (bf16_t*)(a.ws + WS_ACT);
    const float* w3 = a.in[19] + (size_t)j * 64 * 2048; const float* b3 = a.in[20] + j * 2048; const float* decay = a.in[22] + (size_t)j * 2048;
    const _Float16* H2 = (const _Float16*)(a.ws + WS_H2) + ((size_t)j * 8448 + 8192) * 64;
    const float* sw = a.in[13] + (size_t)j * 3 * 1536; const float* sb = a.in[14] + j * 1536; const float* hbias = a.in[23] + j * 1024;
    if (tid < 256) w3c[tid] = w3[(size_t)(tid & 63) * 2048 + (tid >> 6) * 512 + c];
    if (tid < 2) ks[tid * 512] = 0.f;
    __syncthreads();
    float x1c[2], x2c[2];
#pragma unroll
    for (int k = 0; k < 2; ++k) {
        const int idx = tid + NTHR * k;
        {
            const int od = idx >> 8, p = idx & 255, col = od * 512 + c, o = od >> 1, dir = od & 1;
            const f16x8* hr = (const f16x8*)(H2 + (size_t)p * 64); float dot = 0.f;
#pragma unroll
            for (int u8 = 0; u8 < 8; ++u8) { const f16x8 hv = hr[u8];
#pragma unroll
                for (int e = 0; e < 8; ++e) dot += (float)hv[e] * w3c[od * 64 + u8 * 8 + e]; }
            const float val = (dot + b3[col]) * __expf(-(float)p * (1.0f / 256.0f) * fabsf(decay[col]));
            if (dir == 0) ks[o * 512 + 256 + p] = val; else if (p != 0) ks[o * 512 + 256 - p] = val;
        }
        {
            const int b = idx >> 8, t = idx & 255;
            float cv[3];
#pragma unroll
            for (int g = 0; g < 3; ++g) {
                const int ch = g * 512 + c;
                const bf16_t* Ur = U + (size_t)4 * 1536 * 8192 + ((size_t)b * 1536 + ch) * 256 + t;
                const float l = t > 0 ? bf2f(Ur[-1]) : 0.f, m = bf2f(Ur[0]), r = t < 255 ? bf2f(Ur[1]) : 0.f;
                cv[g] = sw[ch] * l + sw[1536 + ch] * m + sw[3072 + ch] * r + sb[ch];
            }
            vc[idx] = cv[0]; x1c[k] = cv[1]; x2c[k] = cv[2];
        }
    }
    __syncthreads();
    const float bias0 = hbias[c], bias1 = hbias[512 + c];
#pragma unroll
    for (int k = 0; k < 2; ++k) {
        const int idx = tid + NTHR * k, b = idx >> 8, t = idx & 255;
        float y = 0.f;
        const LAS float* kp = ks + 256 + t; const LAS f32x4* vp = (const LAS f32x4*)(vc + b * 256);
#pragma unroll 4
        for (int s4 = 0; s4 < 64; ++s4) { const f32x4 v = vp[s4]; y += kp[-4 * s4] * v.x + kp[-4 * s4 - 1] * v.y + kp[-4 * s4 - 2] * v.z + kp[-4 * s4 - 3] * v.w; }
        zc[idx] = x1c[k] * (y + vc[idx] * bias0);
    }
    __syncthreads();
#pragma unroll
    for (int k = 0; k < 2; ++k) {
        const int idx = tid + NTHR * k, b = idx >> 8, t = idx & 255;
        float y = 0.f;
        const LAS float* kp = ks + 512 + 256 + t; const LAS f32x4* vp = (const LAS f32x4*)(zc + b * 256);
#pragma unroll 4
        for (int s4 = 0; s4 < 64; ++s4) { const f32x4 v = vp[s4]; y += kp[-4 * s4] * v.x + kp[-4 * s4 - 1] * v.y + kp[-4 * s4 - 2] * v.z + kp[-4 * s4 - 3] * v.w; }
        ACT[(size_t)(ML + b * 256 + t) * 1024 + c] = (bf16_t)f2bf(x2c[k] * (y + zc[idx] * bias1));
    }
    __syncthreads();
}

#define MFMA32(a_, b_, c_) __builtin_amdgcn_mfma_f32_32x32x16_bf16((a_), (b_), (c_), 0, 0, 0)
#define MFMA16(a_, b_, c_) __builtin_amdgcn_mfma_f32_16x16x32_bf16((a_), (b_), (c_), 0, 0, 0)
__device__ __forceinline__ void attn_unit(KArgsR a, LAS unsigned char* lds, int b, int hh, int qrow0, int kt_lo, int kt_hi, float lam, float osc, const float* subg, int tid) {
    const int lane = tid & 63, wid = tid >> 6, r = lane & 31, h = lane >> 5;
    const bf16_t* Qb = (const bf16_t*)(a.ws + WS_BIG + BIG_Q); const bf16_t* Kb = (const bf16_t*)(a.ws + WS_BIG + BIG_K); const bf16_t* VT = (const bf16_t*)(a.ws + WS_BIG + BIG_VT);
    bf16_t* ACT = (bf16_t*)(a.ws + WS_ACT);
    const int qrow = qrow0 + wid * 32 + r;
    LAS unsigned* osl = (LAS unsigned*)(lds + 53248) + wid * 2048 + lane;
    const int kkey = tid >> 3, kch = tid & 7;
    const bf16_t* vbase = VT + (size_t)((b * 4 + hh) * 128) * NKEY + (size_t)(tid >> 3) * NKEY + (tid & 7) * 8;
#define ATT_LOAD(KR, V0, V1, kt_) do { const int ktt_ = (kt_); const int kb_ = ktt_ < 128 ? b * 8192 + ktt_ * 64 : ML + b * 256 + (ktt_ - 128) * 64; \
        KR = *(const u32x4*)(kcol + (size_t)(kb_ + kkey) * 512); V0 = *(const u32x4*)(vbase + ktt_ * 64); V1 = *(const u32x4*)(vbase + (size_t)64 * NKEY + ktt_ * 64); } while (0)
#define ATT_STORE(KR, V0, V1, slot_) do { LAS unsigned char* ks_ = lds + (slot_) * 26624; LAS unsigned char* vs_ = ks_ + 9216 + (tid >> 3) * 136 + (tid & 7) * 16; \
        *(LAS u32x4*)(ks_ + kkey * 144 + kch * 16) = KR; \
        { u32x2 w0_, w1_; w0_.x = V0.x; w0_.y = V0.y; w1_.x = V0.z; w1_.y = V0.w; *(LAS u32x2*)(vs_) = w0_; *(LAS u32x2*)(vs_ + 8) = w1_; } \
        { u32x2 w0_, w1_; w0_.x = V1.x; w0_.y = V1.y; w1_.x = V1.z; w1_.y = V1.w; *(LAS u32x2*)(vs_ + 64 * 136) = w0_; *(LAS u32x2*)(vs_ + 64 * 136 + 8) = w1_; } } while (0)
#pragma unroll 1
    for (int jj = 0; jj < 2; ++jj) {
        const bf16_t* kcol = Kb + hh * 128 + jj * 64 + kch * 8;
        bf16x8 qf[4];
#pragma unroll
        for (int ks = 0; ks < 4; ++ks) qf[ks] = *(const bf16x8*)(Qb + (size_t)qrow * 512 + hh * 128 + jj * 64 + ks * 16 + h * 8);
        f32x16 o[4];
#pragma unroll
        for (int et = 0; et < 4; ++et)
#pragma unroll
            for (int i = 0; i < 16; ++i) o[et][i] = 0.f;
        float mrun = -INFINITY, lrun = 0.f;
        u32x4 kA, vA0, vA1, kB, vB0, vB1;
        ATT_LOAD(kA, vA0, vA1, kt_lo); ATT_LOAD(kB, vB0, vB1, kt_lo + 1);
        ATT_STORE(kA, vA0, vA1, 0);
        if (kt_lo + 2 < kt_hi) ATT_LOAD(kA, vA0, vA1, kt_lo + 2);
#pragma unroll 1
        for (int kt2 = kt_lo; kt2 < kt_hi; kt2 += 2) {
#pragma unroll
            for (int par = 0; par < 2; ++par) {
                __syncthreads();
                if (par == 0) { ATT_STORE(kB, vB0, vB1, 1); if (kt2 + 3 < kt_hi) ATT_LOAD(kB, vB0, vB1, kt2 + 3); }
                else { if (kt2 + 2 < kt_hi) { ATT_STORE(kA, vA0, vA1, 0); } if (kt2 + 4 < kt_hi) ATT_LOAD(kA, vA0, vA1, kt2 + 4); }
                const LAS unsigned char* Kl = lds + par * 26624; const LAS unsigned char* Vl = Kl + 9216;
                f32x16 s0, s1;
#pragma unroll
                for (int i = 0; i < 16; ++i) { s0[i] = 0.f; s1[i] = 0.f; }
#pragma unroll
                for (int ks = 0; ks < 4; ++ks) {
                    const bf16x8 k0 = *(const LAS bf16x8*)(Kl + r * 144 + (ks * 16 + h * 8) * 2);
                    const bf16x8 k1 = *(const LAS bf16x8*)(Kl + (32 + r) * 144 + (ks * 16 + h * 8) * 2);
                    s0 = MFMA32(k0, qf[ks], s0); s1 = MFMA32(k1, qf[ks], s1);
                }
                float mx = s0[0];
#pragma unroll
                for (int i = 0; i < 16; ++i) { mx = fmaxf(mx, s0[i]); mx = fmaxf(mx, s1[i]); }
                mx = fmaxf(mx, shflx(mx, 32, lane));
                const float mnew = fmaxf(mrun, mx);
                const float alpha = __builtin_amdgcn_exp2f(mrun - mnew);
                float sum = 0.f;
#pragma unroll
                for (int i = 0; i < 16; ++i) { s0[i] = __builtin_amdgcn_exp2f(s0[i] - mnew); s1[i] = __builtin_amdgcn_exp2f(s1[i] - mnew); sum += s0[i] + s1[i]; }
                sum += shflx(sum, 32, lane);
                lrun = lrun * alpha + sum; mrun = mnew;
                if (__builtin_amdgcn_ballot_w64(alpha != 1.0f) != 0ull) {
#pragma unroll
                    for (int et = 0; et < 4; ++et)
#pragma unroll
                        for (int i = 0; i < 16; ++i) o[et][i] *= alpha;
                }
                __builtin_amdgcn_sched_barrier(0);
#pragma unroll
                for (int st = 0; st < 2; ++st)
#pragma unroll
                    for (int s = 0; s < 2; ++s) {
                        u32x4 pw;
                        if (st == 0) { pw.x = pk2(s0[8 * s + 0], s0[8 * s + 1]); pw.y = pk2(s0[8 * s + 2], s0[8 * s + 3]); pw.z = pk2(s0[8 * s + 4], s0[8 * s + 5]); pw.w = pk2(s0[8 * s + 6], s0[8 * s + 7]); }
                        else         { pw.x = pk2(s1[8 * s + 0], s1[8 * s + 1]); pw.y = pk2(s1[8 * s + 2], s1[8 * s + 3]); pw.z = pk2(s1[8 * s + 4], s1[8 * s + 5]); pw.w = pk2(s1[8 * s + 6], s1[8 * s + 7]); }
                        const bf16x8 pf = __builtin_bit_cast(bf16x8, pw);
                        u32x4 vw[4];
#pragma unroll
                        for (int et = 0; et < 4; ++et) {
                            const LAS unsigned char* vp = Vl + (32 * et + r) * 136 + (32 * st + 16 * s + 4 * h) * 2;
                            const u32x2 lo = *(const LAS u32x2*)vp, hi = *(const LAS u32x2*)(vp + 16);
                            vw[et].x = lo.x; vw[et].y = lo.y; vw[et].z = hi.x; vw[et].w = hi.y;
                        }
                        __builtin_amdgcn_s_setprio(1);
#pragma unroll
                        for (int et = 0; et < 4; ++et) o[et] = MFMA32(__builtin_bit_cast(bf16x8, vw[et]), pf, o[et]);
                        __builtin_amdgcn_s_setprio(0);
                        if (st * 2 + s == 1) __builtin_amdgcn_sched_barrier(0);
                    }
            }
        }
        const float inv = 1.0f / lrun;
        if (jj == 0) {
#pragma unroll
            for (int et = 0; et < 4; ++et)
#pragma unroll
                for (int i = 0; i < 8; ++i) osl[(et * 8 + i) * 64] = pk2(o[et][2 * i] * inv, o[et][2 * i + 1] * inv);
        } else {
            float ss = 0.f;
#pragma unroll
            for (int et = 0; et < 4; ++et)
#pragma unroll
                for (int i = 0; i < 16; ++i) { const unsigned pw0 = osl[(et * 8 + (i >> 1)) * 64]; const float p0 = __builtin_bit_cast(float, (i & 1) ? (pw0 & 0xffff0000u) : (pw0 << 16)); const float v = p0 - lam * (o[et][i] * inv); o[et][i] = v; ss += v * v; }
            ss += shflx(ss, 32, lane);
            const float rstd = rsqrtf(ss * (1.0f / 128.0f) + 1e-6f) * osc;
#pragma unroll
            for (int et = 0; et < 4; ++et)
#pragma unroll
                for (int g = 0; g < 4; ++g) {
                    const int e = 32 * et + 8 * g + 4 * h;
                    const f32x4 sg = *(const f32x4*)(subg + e);
                    u32x2 w; w.x = pk2(o[et][4 * g] * rstd * sg.x, o[et][4 * g + 1] * rstd * sg.y); w.y = pk2(o[et][4 * g + 2] * rstd * sg.z, o[et][4 * g + 3] * rstd * sg.w);
                    *(u32x2*)(ACT + (size_t)qrow * 1024 + 512 + hh * 128 + e) = w;
                }
        }
        __syncthreads();
    }
#undef ATT_LOAD
#undef ATT_STORE
}

__device__ __forceinline__ int scan_seq(int d, int k) { return d == 0 ? k : (k < 4 ? 3 - k : 135 - k); }
__device__ __forceinline__ float fsigm(float x) { return __builtin_amdgcn_rcpf(1.0f + __builtin_amdgcn_exp2f(-1.4426950408889634f * x)); }
__device__ __forceinline__ float fgelu(float g) { const float u = 0.7978845608028654f * (g + 0.044715f * g * g * g); return 0.5f * g * (2.0f - 2.0f * __builtin_amdgcn_rcpf(1.0f + __builtin_amdgcn_exp2f(2.8853900817779268f * u))); }
__device__ __forceinline__ void scan_chain(KArgsR a, LAS unsigned char* lds, int j, int cid, int tid) {
    const int d = tid >> 8, ht = tid & 255, lane = tid & 63, hw = (tid >> 6) & 3;
    const int q4 = cid & 3, n = (cid >> 2) & 15, b = cid >> 6;
    const int ch0 = n * 80, cq0 = ch0 + q4 * 20;
    LAS unsigned char* hb = lds + d * 69120;
    LAS float* xraw = (LAS float*)hb; LAS bf16_t* xcb = (LAS bf16_t*)(hb + 21504); LAS bf16_t* Wl = (LAS bf16_t*)(hb + 33792);
    LAS float* al = (LAS float*)(hb + 46080); LAS float* bl = (LAS float*)(hb + 54784); LAS float* hl = (LAS float*)(hb + 63488);
    const bf16_t* XG = (const bf16_t*)(a.ws + WS_BIG); bf16_t* ACT = (bf16_t*)(a.ws + WS_ACT);
    const bf16_t* WSC = (const bf16_t*)(a.ws + WS_WSC) + (size_t)(((j * 2 + d) * 16 + n) * 2) * 7680;
    const float* convw = a.in[31] + (size_t)j * 4 * 1280; const float* convb = a.in[32] + j * 1280;
    const float* ba = a.in[34] + j * 2560 + d * 1280; const float* bx = a.in[36] + j * 2560 + d * 1280; const float* lamp = a.in[37] + j * 2560 + d * 1280;
    for (int idx = ht; idx < 2 * 32 * 12; idx += 256) {
        const int mat = idx / 384, rem = idx % 384, dpl = rem / 12, ck = rem % 12;
        u32x4 v = {0u, 0u, 0u, 0u};
        if (dpl < 20) v = *(const u32x4*)(WSC + (size_t)mat * 7680 + (q4 * 20 + dpl) * 96 + ck * 8);
        *(LAS u32x4*)(Wl + mat * 3072 + dpl * 96 + ck * 8) = v;
    }
    for (int idx = ht; idx < 64 * 16; idx += 256) xcb[(idx >> 4) * 96 + 80 + (idx & 15)] = 0;
    float bav[2], bxv[2], spv[2]; bool val[2];
#pragma unroll
    for (int nt = 0; nt < 2; ++nt) {
        const int dp = 16 * nt + (lane & 15); val[nt] = dp < 20; const int gc = cq0 + (val[nt] ? dp : 0);
        bav[nt] = ba[gc]; bxv[nt] = bx[gc]; spv[nt] = log1pf(__expf(-lamp[gc]));
    }
    const int xrow = (ht / 40) % 6, cp = ht % 40;
    const int tr = (ht / 20) % 12, cgp = ht % 20;
    f32x4 cw4[4], cb4;
#pragma unroll
    for (int kk = 0; kk < 4; ++kk) cw4[kk] = *(const f32x4*)(convw + kk * 1280 + ch0 + 4 * cgp);
    cb4 = *(const f32x4*)(convb + ch0 + 4 * cgp);
    float hcar = 0.f;
    const int sth = ht - 64 * d;
    int otab[3];
#pragma unroll
    for (int r = 0; r < 3; ++r) { const int e = ht + 256 * r; otab[r] = ((e / 10) << 8) | (2 * (e % 10)); }
    unsigned xr[12];
    const bf16_t* xcol = XG + 1280 + ch0 + 2 * cp;
#define SC_PARAMS(S_, T0_, LS_, RB_, kk_) do { const int s__ = scan_seq(d, (kk_)); S_ = s__; if (s__ < 4) { T0_ = s__ * 64; LS_ = 256; RB_ = ML + b * 256; } else { T0_ = (s__ - 4) * 64; LS_ = 8192; RB_ = b * 8192; } } while (0)
#define SC_PREFETCH(T0_, LS_, RB_) do { _Pragma("unroll") for (int p = 0; p < 12; ++p) { int tt = xrow + 6 * p; tt = tt > 66 ? 66 : tt; int t = (T0_) + tt - 2; t = t < 0 ? 0 : (t >= (LS_) ? (LS_) - 1 : t); \
        xr[p] = *(const unsigned*)(xcol + (size_t)((RB_) + t) * 2560); } } while (0)
#define SC_STAGE(T0_, LS_) do { _Pragma("unroll") for (int p = 0; p < 12; ++p) { int tt = xrow + 6 * p; tt = tt > 66 ? 66 : tt; const int t = (T0_) + tt - 2; const unsigned xv = (t >= 0 && t < (LS_)) ? xr[p] : 0u; \
        *(LAS cf2*)(xraw + tt * 80 + 2 * cp) = MKCF(__builtin_bit_cast(float, xv << 16), __builtin_bit_cast(float, xv & 0xffff0000u)); } } while (0)
#define SC_CONV do { _Pragma("unroll") for (int p = 0; p < 6; ++p) { int tt = tr + 12 * p; tt = tt > 63 ? 63 : tt; f32x4 v = cb4; \
        _Pragma("unroll") for (int kk = 0; kk < 4; ++kk) v += cw4[kk] * *(const LAS f32x4*)(xraw + (tt + kk) * 80 + 4 * cgp); \
        u32x2 w; w.x = pk2(v.x, v.y); w.y = pk2(v.z, v.w); *(LAS u32x2*)(xcb + tt * 96 + 4 * cgp) = w; if (p & 1) __builtin_amdgcn_sched_barrier(0); } } while (0)
    int sA, t0A, LsA, rbA, sB = 0, t0B = 0, LsB = 1, rbB = 0;
    SC_PARAMS(sA, t0A, LsA, rbA, 0); SC_PREFETCH(t0A, LsA, rbA); SC_STAGE(t0A, LsA);
    SC_PARAMS(sB, t0B, LsB, rbB, 1); SC_PREFETCH(t0B, LsB, rbB);
    __syncthreads();
    SC_CONV;
    __syncthreads();
#pragma unroll 1
    for (int k = 0; k < NCH; ++k) {
        if (k + 1 < NCH) SC_STAGE(t0B, LsB);
        int sC = 0, t0C = 0, LsC = 1, rbC = 0;
        if (k + 2 < NCH) { SC_PARAMS(sC, t0C, LsC, rbC, k + 2); SC_PREFETCH(t0C, LsC, rbC); }
        {
            const int mt = hw;
            f32x4 ra[2], ri[2];
#pragma unroll
            for (int nt = 0; nt < 2; ++nt) { ra[nt] = (f32x4){0.f, 0.f, 0.f, 0.f}; ri[nt] = (f32x4){0.f, 0.f, 0.f, 0.f}; }
#pragma unroll
            for (int ks = 0; ks < 3; ++ks) {
                const bf16x8 af = *(const LAS bf16x8*)(xcb + (16 * mt + (lane & 15)) * 96 + 32 * ks + 8 * (lane >> 4));
#pragma unroll
                for (int nt = 0; nt < 2; ++nt) {
                    const bf16x8 wfa = *(const LAS bf16x8*)(Wl + (16 * nt + (lane & 15)) * 96 + 32 * ks + 8 * (lane >> 4));
                    const bf16x8 wfx = *(const LAS bf16x8*)(Wl + 3072 + (16 * nt + (lane & 15)) * 96 + 32 * ks + 8 * (lane >> 4));
                    ra[nt] = MFMA16(af, wfa, ra[nt]); ri[nt] = MFMA16(af, wfx, ri[nt]);
                }
            }
#pragma unroll
            for (int nt = 0; nt < 2; ++nt) {
                {
                    const int dp = 16 * nt + (lane & 15), tb = 16 * mt + 4 * (lane >> 4);
                    f32x4 av4, bv4;
#pragma unroll
                    for (int i = 0; i < 4; ++i) {
                        const float rg = fsigm(ra[nt][i] + bav[nt]), ig = fsigm(ri[nt][i] + bxv[nt]);
                        const float la = -8.0f * rg * spv[nt];
                        const float av = __builtin_amdgcn_exp2f(1.4426950408889634f * la);
                        const float em = fmaxf(1.0f - av * av, 0.f);
                        av4[i] = av;
                        bv4[i] = __builtin_amdgcn_sqrtf(em) * ig * bf2f(xcb[(tb + i) * 96 + q4 * 20 + dp]);
                    }
                    *(LAS f32x4*)(al + dp * 68 + tb) = av4; *(LAS f32x4*)(bl + dp * 68 + tb) = bv4;
                }
            }
        }
        __syncthreads();
        const int kother = (d == 0) ? (sA < 4 ? 3 - sA : 135 - sA) : sA;
        const bool first = k < kother, early = (k - kother) >= 2;
        unsigned pvr[3] = {0u, 0u, 0u}, ggr[3] = {0u, 0u, 0u};
        if (early) {
#pragma unroll
            for (int r = 0; r < 3; ++r) {
                const int e = ht + 256 * r;
                if (e < 640) {
                    const int tt = otab[r] >> 8, dp = otab[r] & 255; const size_t row = (size_t)(rbA + t0A + tt);
                    pvr[r] = __hip_atomic_load((unsigned*)(ACT + row * 1280 + cq0 + dp), __ATOMIC_RELAXED, __HIP_MEMORY_SCOPE_AGENT);
                    ggr[r] = *(const unsigned*)(XG + row * 2560 + cq0 + dp);
                }
            }
        }
        if (sth >= 0 && sth < 20) {
            float hv = hcar;
            if (d == 0) {
#pragma unroll 4
                for (int g = 0; g < 16; ++g) {
                    const f32x4 a4 = *(const LAS f32x4*)(al + sth * 68 + 4 * g), b4 = *(const LAS f32x4*)(bl + sth * 68 + 4 * g); f32x4 o4;
                    hv = a4.x * hv + b4.x; o4.x = hv; hv = a4.y * hv + b4.y; o4.y = hv; hv = a4.z * hv + b4.z; o4.z = hv; hv = a4.w * hv + b4.w; o4.w = hv;
                    *(LAS f32x4*)(hl + sth * 68 + 4 * g) = o4;
                }
            } else {
#pragma unroll 4
                for (int g = 15; g >= 0; --g) {
                    const f32x4 a4 = *(const LAS f32x4*)(al + sth * 68 + 4 * g), b4 = *(const LAS f32x4*)(bl + sth * 68 + 4 * g); f32x4 o4;
                    hv = a4.w * hv + b4.w; o4.w = hv; hv = a4.z * hv + b4.z; o4.z = hv; hv = a4.y * hv + b4.y; o4.y = hv; hv = a4.x * hv + b4.x; o4.x = hv;
                    *(LAS f32x4*)(hl + sth * 68 + 4 * g) = o4;
                }
            }
            hcar = hv;
        }
        if (k + 1 < NCH) SC_CONV;
        asm volatile("s_waitcnt vmcnt(12)" ::: "memory");
        __syncthreads();
        {
#pragma unroll
            for (int r = 0; r < 3; ++r) {
                const int e = ht + 256 * r;
                if (e < 640) {
                    const int tt = otab[r] >> 8, dp = otab[r] & 255; const size_t row = (size_t)(rbA + t0A + tt);
                    const float h0 = hl[dp * 68 + tt], h1 = hl[(dp + 1) * 68 + tt];
                    unsigned* ap = (unsigned*)(ACT + row * 1280 + cq0 + dp);
                    if (first) *ap = pk2(h0, h1);
                    else {
                        const unsigned prev = early ? pvr[r] : __hip_atomic_load(ap, __ATOMIC_RELAXED, __HIP_MEMORY_SCOPE_AGENT);
                        const unsigned gg = early ? ggr[r] : *(const unsigned*)(XG + row * 2560 + cq0 + dp);
                        const float p0 = __builtin_bit_cast(float, prev << 16), p1 = __builtin_bit_cast(float, prev & 0xffff0000u);
                        const float g0 = __builtin_bit_cast(float, gg << 16), g1 = __builtin_bit_cast(float, gg & 0xffff0000u);
                        *ap = pk2((p0 + h0) * fgelu(g0), (p1 + h1) * fgelu(g1));
                    }
                }
            }
        }
        sA = sB; t0A = t0B; LsA = LsB; rbA = rbB; sB = sC; t0B = t0C; LsB = LsC; rbB = rbC;
    }
    __syncthreads();
#undef SC_PARAMS
#undef SC_PREFETCH
#undef SC_STAGE
#undef SC_CONV
}

constexpr int NPHASE = 31;
#ifndef ONLY_KIND
#define ONLY_KIND -1
#endif
#define EN(k) (ONLY_KIND < 0 || ONLY_KIND == (k))
#ifdef PROBE_SUB
#define PROBE_SUBV PROBE_SUB
#else
#define PROBE_SUBV 0
#endif
#ifndef MK_MULTI
#define MK_MULTI 0
#endif
__global__ void __launch_bounds__(NTHR, 2) mega_fwd(KArgs a_by_value) {
    extern __shared__ __attribute__((aligned(16))) unsigned char lds_raw[];
    LAS unsigned char* lds = (LAS unsigned char*)lds_raw;
    cg::grid_group grid = cg::this_grid();
    const int tid0 = threadIdx.x;
    if (tid0 < 2) ((LAS unsigned*)(lds + LDS_BARST))[tid0] = 0u;
    __syncthreads();
    (void)xcd_barrier_post((unsigned*)(a_by_value.ws + WS_BAR), (volatile LAS unsigned*)(lds + LDS_BARST));
    const int G = gridDim.x, bid0 = blockIdx.x, ngw = G * 8;
    const int ph_lo = a_by_value.ph_lo, ph_hi = a_by_value.ph_hi;
#pragma unroll 1
#ifdef PROBE_KIND
    for (int pp = 2 * ph_lo; pp < 2 * ph_hi; ++pp) {
        const int ph = pp >> 1;
#else
    for (int ph = ph_lo; ph < ph_hi; ++ph) {
#endif
        const KArgsP ap = opaque_kargs((KArgsP)__builtin_amdgcn_kernarg_segment_ptr());

        KArgsR a = *ap;
#define KOPQ int tid = tid0; asm volatile("" : "+v"(tid)); const int lane = tid & 63, wid = __builtin_amdgcn_readfirstlane(tid >> 6); int bid = bid0; asm volatile("" : "+s"(bid)); bid = __builtin_amdgcn_readfirstlane(bid); (void)lane; int gw = bid * 8 + wid; asm volatile("" : "+v"(gw)); gw = __builtin_amdgcn_readfirstlane(gw); (void)gw; int i = iL; asm volatile("" : "+s"(i)); i = __builtin_amdgcn_readfirstlane(i); const int j = i >> 1; const bool even = (i & 1) == 0; const int Mrows = (i == 3) ? ML : MT; (void)j; (void)even; (void)Mrows; const KArgsP apb_ = opaque_kargs(ap); KArgsR a = *apb_; unsigned char* ws = a.ws; bf16_t* ACT = (bf16_t*)(ws + WS_ACT); bf16_t* BIG = (bf16_t*)(ws + WS_BIG); bf16_t* WB = (bf16_t*)(ws + WS_WB); bf16_t* HCTX = (bf16_t*)(ws + WS_HCTX); float* MODS = (float*)(ws + WS_MODS); bf16_t* H = (bf16_t*)((unsigned char*)a.out + 64 * MiB); const float* mods_i = MODS + (size_t)i * 5 * 6144; const float* srcLat = (i == 0) ? a.in[0] : nullptr; const float* srcCtx = (i == 0) ? a.in[2] : nullptr; (void)ACT; (void)BIG; (void)WB; (void)HCTX; (void)mods_i; (void)srcLat; (void)srcCtx; (void)H;
        int kind, iL = 0, sub = 0;
        if (ph == 0) kind = 0;
        else if (ph >= NPHASE - 2) { kind = 9; sub = ph - (NPHASE - 2); }
        else {
            const int q = ph - 1, st = q % 7; iL = q / 7;
            const bool ev = (iL & 1) == 0;
            kind = st == 0 ? 1 : st == 1 ? (ev ? 2 : 3) : st == 2 ? (ev ? 4 : 5) : st == 3 ? 7 : st == 4 ? 1 : st == 5 ? 3 : 7;
            sub = (st >= 4) ? 1 : 0;
        }
#ifdef PROBE_KIND
        if ((pp & 1) && kind != PROBE_KIND) continue;
#endif
        if (kind == 0 && EN(0)) { KOPQ
            p0_phase(a, lds, tid, lane, wid);
        } else if (kind == 1 && EN(1)) { KOPQ
            if (sub == 0) {
                norm_rows(srcLat, srcCtx, H, HCTX, a.in[6] + i * 1024, mods_i, 0, 1024, ACT, MT, gw, ngw, lane);
                if (even) { for (int it = bid; it < 512; it += G) khat_item(a, lds, j, it, tid); }
            } else {
                norm_rows(nullptr, nullptr, H, HCTX, a.in[7] + i * 1024, mods_i, 3072, 4096, ACT, Mrows, gw, ngw, lane);
            }
        } else if (kind == 2 && EN(2)) { KOPQ
            pg8::Gemm g{ACT, WB + WB_EVIN + (size_t)j * 3072 * 1024, MT, 3072, 1024}; pg8::StaticOrder S; S.init(MT, 3072, G, bid);
            EpiEvenIn E{(bf16_t*)(ws + WS_BIG + BIG_U), (bf16_t*)(ws + WS_BIG + BIG_Q), (bf16_t*)(ws + WS_BIG + BIG_K), (bf16_t*)(ws + WS_BIG + BIG_VT)};
            pg8::gemm_phase<EpiEvenIn, pg8::StaticOrder, true, true>(lds, g, S, E);
        } else if (kind == 3 && EN(3)) { KOPQ
            const int N = sub ? 4096 : 2560;
            const bf16_t* Bt = sub ? WB + WB_W1 + (size_t)i * 4096 * 1024 : WB + WB_ODIN + (size_t)j * 2560 * 1024;
            const int Mg = sub ? Mrows : MT;
            pg8::Gemm g{ACT, Bt, Mg, N, 1024}; pg8::StaticOrder S; S.init(Mg, N, G, bid);
            EpiStore E{BIG, N, sub};
            pg8::gemm_phase<EpiStore, pg8::StaticOrder, true, true>(lds, g, S, E);
        } else if (kind == 4 && EN(4)) { KOPQ
            const float s1 = wave_sum(a.in[24][j * 64 + lane] * a.in[25][j * 64 + lane], lane), s2 = wave_sum(a.in[26][j * 64 + lane] * a.in[27][j * 64 + lane], lane);
            const float lam_init = 0.8f - 0.6f * __expf(-0.3f * (float)i);
            const float lam = __expf(s1) - __expf(s2) + lam_init;
            const float* subg = a.in[28] + j * 128;
#ifdef PROBE_SUB
            const bool rep_ = (pp & 1);
#else
            const bool rep_ = false;
#endif
            if (!rep_ || PROBE_SUBV == 0)
            {
                const int vcu = (G % 8 == 0) ? (bid % 8) * (G / 8) + bid / 8 : bid;
                for (int it = vcu; it < 528; it += G) {
                    int b, hh, qrow0, ktlo;
                    if (it < 512) { b = it >> 7; hh = (it >> 5) & 3; qrow0 = b * 8192 + (it & 31) * 256; ktlo = 0; }
                    else { const int u = it - 512; b = u >> 2; hh = u & 3; qrow0 = ML + b * 256; ktlo = 128; }
                    attn_unit(a, lds, b, hh, qrow0, ktlo, 132, lam, 1.0f - lam_init, subg, tid);
                }
            }
            if (!rep_ || PROBE_SUBV == 1)
            for (int it = bid; it < 1024; it += G) hyena_lat_item(a, lds, j, it >> 1, it & 1, tid);
            if (!rep_ || PROBE_SUBV == 2)
            for (int it = bid; it < 512; it += G) hyena_ctx_item(a, lds, j, it, tid);
        } else if (kind == 5 && EN(5)) { KOPQ
            for (int cid = bid; cid < 256; cid += G) scan_chain(a, lds, j, cid, tid);
        } else if (kind == 7 && EN(7)) { KOPQ
            const int K = sub ? 4096 : (even ? 1024 : 1280);
            const bf16_t* A = sub ? BIG : ACT;
            const bf16_t* Bt = sub ? WB + WB_W2 + (size_t)i * 4096 * 1024 : (even ? WB + WB_EVOUT + (size_t)j * 1024 * 1024 : WB + WB_ODOUT + (size_t)j * 1024 * 1280);
            pg8::Gemm g{A, Bt, Mrows, 1024, K}; pg8::StaticOrder S; S.init(Mrows, 1024, G, bid);
            EpiResid E{sub ? nullptr : srcLat, sub ? nullptr : srcCtx, H, HCTX, mods_i, sub ? 5120 : 2048};
            pg8::gemm_phase<EpiResid, pg8::StaticOrder, true, true>(lds, g, S, E);
        } else { KOPQ
            if (sub == 0) final_norm(H, a.out, (float*)(ws + WS_ACT), a.in[10], gw, ngw, lane);
            else final_copy((const float*)(ws + WS_ACT), a.out + (size_t)16384 * 1024, bid * NTHR + tid, G * NTHR);
        }
        #ifdef PROBE_SYNCS
        if (ph == 0) { for (int e = 0; e < PROBE_SYNCS; ++e) grid.sync(); }
#endif
#ifdef PROBE_KIND
        if (pp + 1 < 2 * ph_hi) grid.sync();
#else
        if (ph + 1 < ph_hi) { if (ph_hi > 4096) grid.sync(); else { XcdBarrier xb_; xb_.bar = (unsigned*)(ap->ws + WS_BAR); xb_.x = xb_xcc_id(); xb_.st = (volatile LAS unsigned*)(lds + LDS_BARST); xcd_barrier(xb_); } }
#endif
    }
}

extern "C" void kernel_launch(void* const* d_in, const int* in_sizes, int n_in, void* d_out, int out_size, void* d_ws, size_t ws_size, hipStream_t stream) {
    static int grid = 0;
    if (grid == 0) {
        if (n_in != 38 || in_sizes[0] != ML * DM || out_size != ML * DM || ws_size < WS_END) {
            fprintf(stderr, "kernel_launch: unexpected shapes: n_in %d in0 %d out %d ws %zu (need %zu)\n", n_in, n_in > 0 ? in_sizes[0] : -1, out_size, ws_size, (size_t)WS_END); grid = -1; return; }
        int dev = 0, cus = 0, per_cu = 0;
        (void)hipGetDevice(&dev); (void)hipDeviceGetAttribute(&cus, hipDeviceAttributeMultiprocessorCount, dev);
        if (hipFuncSetAttribute((const void*)mega_fwd, hipFuncAttributeMaxDynamicSharedMemorySize, LDS_BYTES) != hipSuccess) { fprintf(stderr, "kernel_launch: hipFuncSetAttribute failed\n"); grid = -1; return; }
        if (hipOccupancyMaxActiveBlocksPerMultiprocessor(&per_cu, (const void*)mega_fwd, NTHR, LDS_BYTES) != hipSuccess || per_cu < 1) { fprintf(stderr, "kernel_launch: occupancy query says %d\n", per_cu); per_cu = 1; }
        (void)hipGetLastError();
        grid = cus * 1;
        if (grid <= 0) grid = 256;
    }
    if (grid < 0) return;
    if (hipMemsetAsync((char*)d_ws + WS_BAR, 0, 16384, stream) != hipSuccess) { fprintf(stderr, "kernel_launch: memset of the barrier words failed\n"); return; }
    KArgs a{};
    for (int k = 0; k < 38; ++k) a.in[k] = (const float*)d_in[k];
    a.out = (float*)d_out; a.ws = (unsigned char*)d_ws;
#if MK_MULTI
    for (int p = 0; p < NPHASE; ++p) { a.ph_lo = p; a.ph_hi = p + 1; hipLaunchKernelGGL(mega_fwd, dim3(grid), dim3(NTHR), LDS_BYTES, stream, a); }
#else
    a.ph_lo = 0; a.ph_hi = NPHASE;
    void* args[] = {&a};
    hipError_t e = hipLaunchCooperativeKernel((const void*)mega_fwd, dim3(grid), dim3(NTHR), args, LDS_BYTES, stream);
    if (e != hipSuccess) fprintf(stderr, "kernel_launch: cooperative launch failed: %s (grid %d)\n", hipGetErrorString(e), grid);
#endif
}
```

```cpp
#include <hip/hip_runtime.h>
#include <hip/hip_cooperative_groups.h>
#include <cstdio>
#include <cstdint>
namespace cg = cooperative_groups;
namespace pg8 {
#define PG8_LAS __attribute__((address_space(3)))
typedef unsigned short bf16_t;
typedef short bf16x8 __attribute__((ext_vector_type(8)));
typedef float f32x4 __attribute__((ext_vector_type(4)));
typedef unsigned u32x4 __attribute__((ext_vector_type(4)));
constexpr int BM = 256, BK = 64, HALF = 128, HTB = HALF * BK * 2  , STAGE_BYTES = 8 * HTB, NXCD = 8, WGM = 8;

__host__ __device__ __forceinline__ int lds_byte(int r, int c) { const int st = (r >> 4) * 2 + (c >> 5), rr = r & 15, cc = c & 31, ob = rr * 64 + cc * 2; return st * 1024 + (ob ^ (((ob >> 9) & 1) << 5)); }
__host__ __device__ __forceinline__ void stage_rc(int b, int& R, int& C) { const int st = b / 1024, sb = b % 1024, swz = sb ^ (((sb >> 9) & 1) << 5); R = (st >> 1) * 16 + swz / 64; C = (st & 1) * 32 + (swz % 64) / 2; }
__host__ __device__ __forceinline__ int perm32(int rho) { const int n = rho >> 4, i = rho & 15; return 8 * (i >> 2) + 4 * n + (i & 3); }

struct Unit { int pm, pn; };
struct Gemm { const bf16_t* A; const bf16_t* Bt; int M, N, K; };

struct StaticOrder {
    int nM, nN, nwg, G, c;
    __host__ __device__ void init(int M, int N, int G_, int c_) { nM = M / BM; nN = N / BM; nwg = nM * nN; G = G_; c = c_; }
    __host__ __device__ bool next(int i, Unit& u) const {
        const long L = (long)i * G + c; if (L >= nwg) return false;
        int wgid = (int)L; { const int q = nwg / NXCD, r = nwg % NXCD, xcd = wgid % NXCD, off = wgid / NXCD; wgid = (xcd < r ? xcd * (q + 1) : r * (q + 1) + (xcd - r) * q) + off; }
        const int nig = WGM * nN, gid = wgid / nig, fm = gid * WGM, gsz = (nM - fm) < WGM ? (nM - fm) : WGM;
        u.pm = fm + ((wgid % nig) % gsz); u.pn = (wgid % nig) / gsz; return true;
    }
    __device__ __forceinline__ void a_ready(const Unit&) const {}
    __device__ __forceinline__ void done(const Unit&) const {}
};

__device__ __forceinline__ unsigned cvt_pk_bf16(float lo, float hi) { unsigned r; asm volatile("v_cvt_pk_bf16_f32 %0, %1, %2" : "=v"(r) : "v"(lo), "v"(hi)); return r; }
template <class Epi, class Sched, bool ALIGN_EPI = false, bool SP2 = false>
__device__ __forceinline__ void gemm_phase(PG8_LAS unsigned char* lds, const Gemm g, const Sched& S, const Epi& E) {
    int tid_op = threadIdx.x; asm volatile("" : "+v"(tid_op));
    const int tid = tid_op, wid = __builtin_amdgcn_readfirstlane(tid >> 6), lane = tid & 63, wr = wid >> 2, wc = wid & 3, fr = lane & 15, fq = lane >> 4;
    const int K = g.K, nt = K / BK;
    unsigned voffA[2], voffB[2];
#pragma unroll
    for (int i = 0; i < 2; ++i) { int R, C; stage_rc(tid * 16 + i * 8192, R, C); const int Rb = Epi::PERM ? ((R & ~31) + perm32(R & 31)) : R;
        voffA[i] = (unsigned)(R * K + C) * 2u; voffB[i] = (unsigned)(Rb * K + C) * 2u; }
    const size_t kstep = (size_t)(BK * 2);
    const size_t hstep = (size_t)HALF * K * 2;
    const size_t tstep = 2 * hstep;
    const unsigned ldsw = (unsigned)wid * 1024u;
    const int aoff = lds_byte(wr * 64 + fr, fq * 8), boff = lds_byte(wc * 32 + fr, fq * 8);
#define PG8_SA(b, h) (((b) * 2 + (h)) * HTB)
#define PG8_SB(b, h) ((4 + (b) * 2 + (h)) * HTB)
#define PG8_STAGE(bufoff, gbase, voff) do { _Pragma("unroll") for (int _i = 0; _i < 2; ++_i) \
        __builtin_amdgcn_global_load_lds((const unsigned*)((const char*)(gbase) + (voff)[_i]), (PG8_LAS unsigned*)(lds + (bufoff) + ldsw + _i * 8192), 16, 0, 0); } while (0)
#define PG8_LDA(dst, b, h) do { _Pragma("unroll") for (int m = 0; m < 4; ++m) _Pragma("unroll") for (int k = 0; k < 2; ++k) dst[m][k] = *(const PG8_LAS bf16x8*)(lds + PG8_SA(b, h) + aoff + m * 2048 + k * 1024); } while (0)
#define PG8_LDB(dst, b, h) do { _Pragma("unroll") for (int n = 0; n < 2; ++n) _Pragma("unroll") for (int k = 0; k < 2; ++k) dst[n][k] = *(const PG8_LAS bf16x8*)(lds + PG8_SB(b, h) + boff + n * 2048 + k * 1024); } while (0)
#define PG8_MMA(ai, bj, At, Bt) do { __builtin_amdgcn_s_setprio(1); _Pragma("unroll") for (int m = 0; m < 4; ++m) _Pragma("unroll") for (int n = 0; n < 2; ++n) _Pragma("unroll") for (int k = 0; k < 2; ++k) \
        acc[ai][bj][m][n] = __builtin_amdgcn_mfma_f32_16x16x32_bf16(Bt[n][k], At[m][k], acc[ai][bj][m][n], 0, 0, 0); __builtin_amdgcn_s_setprio(0); } while (0)
#define PG8_WAIT_V(n) asm volatile("s_waitcnt vmcnt(" #n ")" ::: "memory")
#define PG8_WAIT_L(n) asm volatile("s_waitcnt lgkmcnt(" #n ")" ::: "memory")
#define PG8_BAR __builtin_amdgcn_s_barrier()
#define PG8_SCHED __builtin_amdgcn_sched_barrier(0)
    Unit cur, nxt; int ui = 0;
    if (!S.next(0, cur)) return;
    f32x4 acc[2][2][4][2];
#pragma unroll
    for (int a = 0; a < 2; ++a)
#pragma unroll
        for (int b = 0; b < 2; ++b)
#pragma unroll
            for (int m = 0; m < 4; ++m)
#pragma unroll
                for (int n = 0; n < 2; ++n) acc[a][b][m][n] = (f32x4){0.f, 0.f, 0.f, 0.f};
    bf16x8 At[4][2], B0[2][2], B1[2][2];
    const char* cA = (const char*)g.A + (size_t)cur.pm * tstep; const char* cB = (const char*)g.Bt + (size_t)cur.pn * tstep;
    S.a_ready(cur);
    if constexpr (SP2) {
        PG8_STAGE(PG8_SB(0, 0), cB, voffB); PG8_STAGE(PG8_SB(0, 1), cB + hstep, voffB); PG8_STAGE(PG8_SA(0, 0), cA, voffA); PG8_STAGE(PG8_SA(0, 1), cA + hstep, voffA);
        if (wr == 1) PG8_BAR;
        PG8_WAIT_V(2); PG8_BAR;
        PG8_STAGE(PG8_SB(1, 0), cB + kstep, voffB); PG8_STAGE(PG8_SA(1, 0), cA + kstep, voffA); PG8_STAGE(PG8_SB(1, 1), cB + hstep + kstep, voffB);
        PG8_WAIT_V(6); PG8_BAR;
    } else {
        PG8_STAGE(PG8_SB(0, 0), cB, voffB); PG8_STAGE(PG8_SA(0, 0), cA, voffA); PG8_STAGE(PG8_SB(0, 1), cB + hstep, voffB); PG8_STAGE(PG8_SA(0, 1), cA + hstep, voffA);
        if (wr == 1) PG8_BAR;
        PG8_WAIT_V(4); PG8_BAR;
        PG8_STAGE(PG8_SB(1, 0), cB + kstep, voffB); PG8_STAGE(PG8_SA(1, 0), cA + kstep, voffA); PG8_STAGE(PG8_SB(1, 1), cB + hstep + kstep, voffB);
        PG8_WAIT_V(6); PG8_BAR;
    }
    for (;;) {
        const bool has_next = S.next(ui + 1, nxt);
        const char* nA = has_next ? (const char*)g.A + (size_t)nxt.pm * tstep : cA; const char* nB = has_next ? (const char*)g.Bt + (size_t)nxt.pn * tstep : cB;
        for (int t = 0; t < nt; t += 2) {
            const bool last = (t == nt - 2);
            const char* a1 = cA + (size_t)(t + 1) * kstep;
            const char* a2 = last ? nA : cA + (size_t)(t + 2) * kstep; const char* b2 = last ? nB : cB + (size_t)(t + 2) * kstep;
            const char* a3 = a2 + kstep; const char* b3 = b2 + kstep;
            if (last && has_next) S.a_ready(nxt);
            if constexpr (SP2) {
            PG8_LDB(B0, 0, 0); PG8_LDB(B1, 0, 1); PG8_SCHED; PG8_LDA(At, 0, 0); PG8_STAGE(PG8_SA(1, 1), a1 + hstep, voffA);
            PG8_WAIT_V(8); PG8_WAIT_L(0); PG8_BAR; PG8_MMA(0, 0, At, B0); PG8_MMA(0, 1, At, B1); PG8_BAR; PG8_SCHED;
            PG8_LDA(At, 0, 1); PG8_STAGE(PG8_SB(0, 0), b2, voffB); PG8_STAGE(PG8_SB(0, 1), b2 + hstep, voffB); PG8_STAGE(PG8_SA(0, 0), a2, voffA);
            PG8_WAIT_V(8); PG8_WAIT_L(0); PG8_BAR; PG8_MMA(1, 0, At, B0); PG8_MMA(1, 1, At, B1); PG8_BAR; PG8_SCHED;
            PG8_LDB(B0, 1, 0); PG8_LDB(B1, 1, 1); PG8_SCHED; PG8_LDA(At, 1, 0); PG8_STAGE(PG8_SA(0, 1), a2 + hstep, voffA);
            PG8_WAIT_V(8); PG8_WAIT_L(0); PG8_BAR; PG8_MMA(0, 0, At, B0); PG8_MMA(0, 1, At, B1); PG8_BAR; PG8_SCHED;
            PG8_LDA(At, 1, 1); PG8_STAGE(PG8_SB(1, 0), b3, voffB); PG8_STAGE(PG8_SB(1, 1), b3 + hstep, voffB); PG8_STAGE(PG8_SA(1, 0), a3, voffA);
            PG8_WAIT_V(8); PG8_WAIT_L(0); PG8_BAR; PG8_MMA(1, 0, At, B0); PG8_MMA(1, 1, At, B1); PG8_BAR; PG8_SCHED;
            } else {
            PG8_LDB(B0, 0, 0); PG8_SCHED; PG8_LDA(At, 0, 0); PG8_STAGE(PG8_SA(1, 1), a1 + hstep, voffA);
            PG8_WAIT_L(8); PG8_BAR; PG8_WAIT_L(0); PG8_MMA(0, 0, At, B0); PG8_BAR; PG8_SCHED;
            PG8_LDB(B1, 0, 1); PG8_STAGE(PG8_SB(0, 0), b2, voffB);
            PG8_BAR; PG8_WAIT_L(0); PG8_MMA(0, 1, At, B1); PG8_BAR;
            PG8_LDA(At, 0, 1); PG8_STAGE(PG8_SA(0, 0), a2, voffA);
            PG8_BAR; PG8_WAIT_L(0); PG8_MMA(1, 0, At, B0); PG8_BAR; PG8_SCHED;
            PG8_STAGE(PG8_SB(0, 1), b2 + hstep, voffB);
            PG8_WAIT_V(6); PG8_BAR; PG8_MMA(1, 1, At, B1); PG8_BAR;
            PG8_LDB(B0, 1, 0); PG8_SCHED; PG8_LDA(At, 1, 0); PG8_STAGE(PG8_SA(0, 1), a2 + hstep, voffA);
            PG8_WAIT_L(8); PG8_BAR; PG8_WAIT_L(0); PG8_MMA(0, 0, At, B0); PG8_BAR; PG8_SCHED;
            PG8_LDB(B1, 1, 1); PG8_STAGE(PG8_SB(1, 0), b3, voffB);
            PG8_BAR; PG8_WAIT_L(0); PG8_MMA(0, 1, At, B1); PG8_BAR;
            PG8_LDA(At, 1, 1); PG8_STAGE(PG8_SA(1, 0), a3, voffA);
            PG8_BAR; PG8_WAIT_L(0); PG8_MMA(1, 0, At, B0); PG8_BAR; PG8_SCHED;
            PG8_STAGE(PG8_SB(1, 1), b3 + hstep, voffB);
            PG8_WAIT_V(6); PG8_BAR; PG8_MMA(1, 1, At, B1); PG8_BAR;
            }
        }
        if constexpr (ALIGN_EPI) { if (wr == 0) PG8_BAR; }
        if constexpr (!Epi::AFTER_DRAIN) { E(acc, cur, wr, wc, fr, fq); S.done(cur); }
        if (!has_next) break;
#pragma unroll
        for (int a = 0; a < 2; ++a)
#pragma unroll
            for (int b = 0; b < 2; ++b)
#pragma unroll
                for (int m = 0; m < 4; ++m)
#pragma unroll
                    for (int n = 0; n < 2; ++n) acc[a][b][m][n] = (f32x4){0.f, 0.f, 0.f, 0.f};
        cur = nxt; cA = nA; cB = nB; ++ui;
        if constexpr (ALIGN_EPI) { if (wr == 1) PG8_BAR; }
    }
    PG8_WAIT_V(0);
    if constexpr (!ALIGN_EPI) { if (wr == 0) PG8_BAR; }
    PG8_BAR;
    if constexpr (Epi::AFTER_DRAIN) { E.fused(acc, cur, wr, wc, fr, fq, lds, wid, lane); S.done(cur); }
#undef PG8_SA
#undef PG8_SB
#undef PG8_STAGE
#undef PG8_LDA
#undef PG8_LDB
#undef PG8_MMA
#undef PG8_WAIT_V
#undef PG8_WAIT_L
#undef PG8_BAR
#undef PG8_SCHED
}
}

#define LAS __attribute__((address_space(3)))
typedef unsigned short bf16_t;
typedef short bf16x8 __attribute__((ext_vector_type(8)));
typedef float f32x4 __attribute__((ext_vector_type(4)));
typedef float f32x16 __attribute__((ext_vector_type(16)));
typedef unsigned u32x4 __attribute__((ext_vector_type(4)));
typedef unsigned u32x2 __attribute__((ext_vector_type(2)));
typedef _Float16 h16x2 __attribute__((ext_vector_type(2)));
typedef float cf2 __attribute__((ext_vector_type(2)));
__device__ __forceinline__ cf2 MKCF(float x, float y) { cf2 r; r.x = x; r.y = y; return r; }

constexpr int NB = 4, SEQ = 8192, DM = 1024, LC = 256;
constexpr int ML = NB * SEQ, MC = NB * LC, MT = ML + MC;
constexpr int NKEY = SEQ + LC;
constexpr int NTHR = 512;
constexpr int LDS_BYTES = 147456, LDS_BARST = 147200;
constexpr size_t MiB = 1u << 20;
constexpr size_t WS_BIG = 0, WS_ACT = 264 * MiB, WS_HCTX = 347 * MiB, WS_WB = 351 * MiB, WS_MODS = 446 * MiB, WS_H2 = 447 * MiB, WS_WSC = 452 * MiB, WS_BAR = 455 * MiB, WS_END = 456 * MiB;
constexpr size_t BIG_U = 0, BIG_Q = 99 * MiB, BIG_K = 132 * MiB, BIG_VT = 165 * MiB, BIG_KH = 198 * MiB;
constexpr size_t WB_W1 = 0, WB_W2 = WB_W1 + 4ull * 4096 * 1024, WB_EVIN = WB_W2 + 4ull * 4096 * 1024, WB_EVOUT = WB_EVIN + 2ull * 3072 * 1024,
                 WB_ODIN = WB_EVOUT + 2ull * 1024 * 1024, WB_ODOUT = WB_ODIN + 2ull * 2560 * 1024, WB_ENDE = WB_ODOUT + 2ull * 1024 * 1280;
static_assert(WB_ENDE * 2 <= 95 * MiB, "weights");
constexpr int NCH = 132;

__device__ __forceinline__ unsigned f2bf(float f) { unsigned u = __builtin_bit_cast(unsigned, f); return (u + 0x7fffu + ((u >> 16) & 1u)) >> 16; }
__device__ __forceinline__ unsigned pk2(float lo, float hi) { unsigned r; asm("v_cvt_pk_bf16_f32 %0, %1, %2" : "=v"(r) : "v"(lo), "v"(hi)); return r; }
__device__ __forceinline__ float bf2f(bf16_t h) { return __builtin_bit_cast(float, (unsigned)h << 16); }
__device__ __forceinline__ float shflx(float v, int m, int lane) { return __builtin_bit_cast(float, __builtin_amdgcn_ds_bpermute((lane ^ m) << 2, __builtin_bit_cast(int, v))); }
__device__ __forceinline__ float wave_sum(float v, int lane) {
#pragma unroll
    for (int o = 1; o < 64; o <<= 1) v += shflx(v, o, lane);
    return v;
}
__device__ __forceinline__ float sin_rev(float r) { return __builtin_amdgcn_sinf(r); }
__device__ __forceinline__ float cos_rev(float r) { return __builtin_amdgcn_cosf(r); }
__device__ __forceinline__ float fsin(float x) { float r = x * 0.15915494309189535f; r = r - floorf(r); return __builtin_amdgcn_sinf(r); }
__device__ __forceinline__ float fcos(float x) { float r = x * 0.15915494309189535f; r = r - floorf(r); return __builtin_amdgcn_cosf(r); }
__device__ __forceinline__ float sigmoidf_(float x) { return 1.0f / (1.0f + __expf(-x)); }
__device__ __forceinline__ float gelu_tanh(float g) { const float u = 0.7978845608028654f * (g + 0.044715f * g * g * g); const float t = 1.0f - 2.0f / (1.0f + __expf(2.0f * u)); return 0.5f * g * (1.0f + t); }

struct EpiStore {
    static constexpr bool PERM = true, AFTER_DRAIN = false;
    bf16_t* O; int ldc; int act;
    __device__ __forceinline__ void operator()(const f32x4 (&acc)[2][2][4][2], const pg8::Unit& u, int wr, int wc, int fr_, int fq_) const {
        int fr = fr_, fq = fq_; asm volatile("" : "+v"(fr), "+v"(fq));
        const int row0 = u.pm * 256 + wr * 64 + fr, col0 = u.pn * 256 + wc * 32 + 8 * fq;
#pragma unroll
        for (int ai = 0; ai < 2; ++ai)
#pragma unroll
            for (int m = 0; m < 4; ++m) {
                bf16_t* rowp = O + (size_t)(row0 + ai * 128 + m * 16) * ldc + col0;
#pragma unroll
                for (int bj = 0; bj < 2; ++bj) {
                    f32x4 v0 = acc[ai][bj][m][0], v1 = acc[ai][bj][m][1];
                    if (act) {
#pragma unroll
                        for (int x = 0; x < 4; ++x) { float a = fmaxf(v0[x], 0.f), b = fmaxf(v1[x], 0.f); v0[x] = a * a; v1[x] = b * b; }
                    }
                    u32x4 w; w.x = pk2(v0[0], v0[1]); w.y = pk2(v0[2], v0[3]); w.z = pk2(v1[0], v1[1]); w.w = pk2(v1[2], v1[3]);
                    *(u32x4*)(rowp + bj * 128) = w;
                }
            }
    }
};

struct EpiResid {
    static constexpr bool PERM = true, AFTER_DRAIN = false;
    const float* srcLat; const float* srcCtx; bf16_t* HLat; bf16_t* HCtx; const float* mods; int gateOff;
    __device__ __forceinline__ void operator()(const f32x4 (&acc)[2][2][4][2], const pg8::Unit& u, int wr, int wc, int fr_, int fq_) const {
        int fr = fr_, fq = fq_; asm volatile("" : "+v"(fr), "+v"(fq));
        const int row0 = u.pm * 256 + wr * 64 + fr, col0 = u.pn * 256 + wc * 32 + 8 * fq;
        const int rowt = u.pm * 256;
        const float* gp = mods + (rowt < ML ? (rowt >> 13) : 4) * 6144 + gateOff + col0;
        f32x4 g[2][2];
#pragma unroll
        for (int bj = 0; bj < 2; ++bj) { g[bj][0] = *(const f32x4*)(gp + bj * 128); g[bj][1] = *(const f32x4*)(gp + bj * 128 + 4); }
        const bool f32src = srcLat != nullptr;
#pragma unroll
        for (int ai = 0; ai < 2; ++ai)
#pragma unroll
            for (int m = 0; m < 4; ++m) {
                const int row = row0 + ai * 128 + m * 16;
                const size_t off = (row < ML) ? (size_t)row * 1024 + col0 : (size_t)(row - ML) * 1024 + col0;
                bf16_t* dp = ((row < ML) ? HLat : HCtx) + off;
#pragma unroll
                for (int bj = 0; bj < 2; ++bj) {
                    f32x4 s0, s1;
                    if (f32src) { const float* sp = ((row < ML) ? srcLat : srcCtx) + off + bj * 128; s0 = *(const f32x4*)sp; s1 = *(const f32x4*)(sp + 4); }
                    else { const u32x4 w = *(const u32x4*)(dp + bj * 128);
                        s0.x = __builtin_bit_cast(float, w.x << 16); s0.y = __builtin_bit_cast(float, w.x & 0xffff0000u); s0.z = __builtin_bit_cast(float, w.y << 16); s0.w = __builtin_bit_cast(float, w.y & 0xffff0000u);
                        s1.x = __builtin_bit_cast(float, w.z << 16); s1.y = __builtin_bit_cast(float, w.z & 0xffff0000u); s1.z = __builtin_bit_cast(float, w.w << 16); s1.w = __builtin_bit_cast(float, w.w & 0xffff0000u); }
                    const f32x4 o0 = s0 + g[bj][0] * acc[ai][bj][m][0], o1 = s1 + g[bj][1] * acc[ai][bj][m][1];
                    u32x4 ow; ow.x = pk2(o0.x, o0.y); ow.y = pk2(o0.z, o0.w); ow.z = pk2(o1.x, o1.y); ow.w = pk2(o1.z, o1.w);
                    *(u32x4*)(dp + bj * 128) = ow;
                }
            }
    }
};

struct EpiEvenIn {
    static constexpr bool PERM = true, AFTER_DRAIN = false;
    bf16_t *U, *Q, *K, *VT;
    __device__ __forceinline__ void operator()(const f32x4 (&acc)[2][2][4][2], const pg8::Unit& u, int wr, int wc, int fr_, int fq_) const {
        int fr = fr_, fq = fq_; asm volatile("" : "+v"(fr), "+v"(fq));
        const int row0 = u.pm * 256 + wr * 64 + fr;
        const int pn = u.pn;
        if (pn < 6) {
            const int col0 = pn * 256 + wc * 32 + 8 * fq;
#pragma unroll
            for (int ai = 0; ai < 2; ++ai)
#pragma unroll
                for (int m = 0; m < 4; ++m) {
                    const int row = row0 + ai * 128 + m * 16;
                    bf16_t* base; size_t cs;
                    if (row < ML) { base = U + (size_t)(row >> 13) * 1536 * 8192 + (row & 8191); cs = 8192; }
                    else { const int rr = row - ML; base = U + (size_t)4 * 1536 * 8192 + (size_t)(rr >> 8) * 1536 * 256 + (rr & 255); cs = 256; }
#pragma unroll
                    for (int bj = 0; bj < 2; ++bj) {
                        bf16_t* cpn = base + (size_t)(col0 + bj * 128) * cs;
                        const f32x4 v0 = acc[ai][bj][m][0], v1 = acc[ai][bj][m][1];
                        const unsigned w0 = pk2(v0[0], v0[1]), w1 = pk2(v0[2], v0[3]), w2 = pk2(v1[0], v1[1]), w3 = pk2(v1[2], v1[3]);
                        cpn[0] = (bf16_t)w0; cpn[cs] = (bf16_t)(w0 >> 16); cpn[2 * cs] = (bf16_t)w1; cpn[3 * cs] = (bf16_t)(w1 >> 16);
                        cpn[4 * cs] = (bf16_t)w2; cpn[5 * cs] = (bf16_t)(w2 >> 16); cpn[6 * cs] = (bf16_t)w3; cpn[7 * cs] = (bf16_t)(w3 >> 16);
                    }
                }
        } else if (pn < 10) {
            const bool isq = pn < 8;
            bf16_t* O = isq ? Q : K;
            const int col0 = ((pn - 6) & 1) * 256 + wc * 32 + 8 * fq;
            const float osc = isq ? 0.18033688011112042f : 1.0f;
            const bool lat = (u.pm * 256) < ML;
            const float fbase = -(float)(8 * (fq & 1)) * 0.8304820237218406f;
            const float sgn = (fq < 2) ? -1.0f : 1.0f;
#pragma unroll
            for (int ai = 0; ai < 2; ++ai)
#pragma unroll
                for (int m = 0; m < 4; ++m) {
                    const int row = row0 + ai * 128 + m * 16;
                    const int t = row & 8191;
                    const float pos = (float)((wc & 1) ? (t & 63) : (t >> 6));
                    bf16_t* rowp = O + (size_t)row * 512 + col0;
                    float o0[8], o1[8];
#pragma unroll
                    for (int e = 0; e < 8; ++e) {
                        float rv = pos * (__builtin_amdgcn_exp2f(fbase - (float)e * 0.8304820237218406f) * 0.15915494309189535f); rv = rv - floorf(rv);
                        const float cs = lat ? cos_rev(rv) : 1.0f, sn = (lat ? sin_rev(rv) : 0.0f) * sgn;
                        const float va = acc[ai][0][m][e >> 2][e & 3], vb = acc[ai][1][m][e >> 2][e & 3];
                        const float pa = shflx(va, 32, fq * 16 + fr), pb = shflx(vb, 32, fq * 16 + fr);
                        o0[e] = (va * cs + pa * sn) * osc; o1[e] = (vb * cs + pb * sn) * osc;
                    }
                    { u32x4 w; w.x = pk2(o0[0], o0[1]); w.y = pk2(o0[2], o0[3]); w.z = pk2(o0[4], o0[5]); w.w = pk2(o0[6], o0[7]); *(u32x4*)(rowp) = w; }
                    { u32x4 w; w.x = pk2(o1[0], o1[1]); w.y = pk2(o1[2], o1[3]); w.z = pk2(o1[4], o1[5]); w.w = pk2(o1[6], o1[7]); *(u32x4*)(rowp + 128) = w; }
                }
        } else {
#pragma unroll
            for (int ai = 0; ai < 2; ++ai)
#pragma unroll
                for (int m = 0; m < 4; ++m) {
                    const int row = row0 + ai * 128 + m * 16;
                    int b, key;
                    if (row < ML) { b = row >> 13; key = row & 8191; } else { const int rr = row - ML; b = rr >> 8; key = 8192 + (rr & 255); }
#pragma unroll
                    for (int bj = 0; bj < 2; ++bj) {
                        const int hh = (pn - 10) * 2 + bj;
                        bf16_t* vp = VT + ((size_t)(b * 4 + hh) * 128 + wc * 32 + 8 * fq) * NKEY + key;
#pragma unroll
                        for (int x = 0; x < 4; ++x) { vp[(size_t)x * NKEY] = (bf16_t)f2bf(acc[ai][bj][m][0][x]); vp[(size_t)(4 + x) * NKEY] = (bf16_t)f2bf(acc[ai][bj][m][1][x]); }
                    }
                }
        }
    }
};

__device__ __forceinline__ void load_row16(const float* f32p, const bf16_t* b16p, int lane, float (&v)[16]) {
    if (f32p) {
#pragma unroll
        for (int j = 0; j < 2; ++j) { const f32x4 a0 = *(const f32x4*)(f32p + 8 * lane + 512 * j), a1 = *(const f32x4*)(f32p + 8 * lane + 512 * j + 4);
            v[8 * j] = a0.x; v[8 * j + 1] = a0.y; v[8 * j + 2] = a0.z; v[8 * j + 3] = a0.w; v[8 * j + 4] = a1.x; v[8 * j + 5] = a1.y; v[8 * j + 6] = a1.z; v[8 * j + 7] = a1.w; }
    } else {
#pragma unroll
        for (int j = 0; j < 2; ++j) { const u32x4 w = *(const u32x4*)(b16p + 8 * lane + 512 * j);
            v[8 * j] = __builtin_bit_cast(float, w.x << 16); v[8 * j + 1] = __builtin_bit_cast(float, w.x & 0xffff0000u); v[8 * j + 2] = __builtin_bit_cast(float, w.y << 16); v[8 * j + 3] = __builtin_bit_cast(float, w.y & 0xffff0000u);
            v[8 * j + 4] = __builtin_bit_cast(float, w.z << 16); v[8 * j + 5] = __builtin_bit_cast(float, w.z & 0xffff0000u); v[8 * j + 6] = __builtin_bit_cast(float, w.w << 16); v[8 * j + 7] = __builtin_bit_cast(float, w.w & 0xffff0000u); }
    }
}
__device__ __forceinline__ void norm_rows(const float* srcLat, const float* srcCtx, const bf16_t* HLat, const bf16_t* HCtx, const float* g, const float* mods, int shOff, int scOff, bf16_t* A, int nrows, int gw, int ngw, int lane) {
    for (int row = gw; row < nrows; row += ngw) {
        const float* md = mods + (row < ML ? (row >> 13) : 4) * 6144;
        const size_t off = (row < ML) ? (size_t)row * 1024 : (size_t)(row - ML) * 1024;
        float v[16];
        load_row16(srcLat ? ((row < ML) ? srcLat : srcCtx) + off : nullptr, ((row < ML) ? HLat : HCtx) + off, lane, v);
        float ss = 0.f;
#pragma unroll
        for (int e = 0; e < 16; ++e) ss += v[e] * v[e];
        ss = wave_sum(ss, lane);
        const float rstd = rsqrtf(ss * (1.0f / 1024.0f) + 1e-6f);
#pragma unroll
        for (int j = 0; j < 2; ++j) {
            const int k = 8 * lane + 512 * j;
            float y[8];
#pragma unroll
            for (int hq = 0; hq < 2; ++hq) {
                const f32x4 gg = *(const f32x4*)(g + k + 4 * hq), sc = *(const f32x4*)(md + scOff + k + 4 * hq), sh = *(const f32x4*)(md + shOff + k + 4 * hq);
                y[4 * hq] = v[8 * j + 4 * hq] * rstd * gg.x * (sc.x + 1.0f) + sh.x; y[4 * hq + 1] = v[8 * j + 4 * hq + 1] * rstd * gg.y * (sc.y + 1.0f) + sh.y;
                y[4 * hq + 2] = v[8 * j + 4 * hq + 2] * rstd * gg.z * (sc.z + 1.0f) + sh.z; y[4 * hq + 3] = v[8 * j + 4 * hq + 3] * rstd * gg.w * (sc.w + 1.0f) + sh.w;
            }
            u32x4 w; w.x = pk2(y[0], y[1]); w.y = pk2(y[2], y[3]); w.z = pk2(y[4], y[5]); w.w = pk2(y[6], y[7]);
            *(u32x4*)(A + (size_t)row * 1024 + k) = w;
        }
    }
}
__device__ __forceinline__ void final_norm(const bf16_t* H16, float* out, float* tmp, const float* g, int gw, int ngw, int lane) {
    for (int row = gw; row < ML; row += ngw) {
        float v[16];
        load_row16(nullptr, H16 + (size_t)row * 1024, lane, v);
        float ss = 0.f;
#pragma unroll
        for (int e = 0; e < 16; ++e) ss += v[e] * v[e];
        ss = wave_sum(ss, lane);
        const float rstd = rsqrtf(ss * (1.0f / 1024.0f) + 1e-6f);
        float* dst = (row < 16384) ? out + (size_t)row * 1024 : tmp + (size_t)(row - 16384) * 1024;
#pragma unroll
        for (int j = 0; j < 2; ++j)
#pragma unroll
            for (int hq = 0; hq < 2; ++hq) {
                const int k = 8 * lane + 512 * j + 4 * hq; const f32x4 gg = *(const f32x4*)(g + k);
                f32x4 y; y.x = v[8 * j + 4 * hq] * rstd * gg.x; y.y = v[8 * j + 4 * hq + 1] * rstd * gg.y; y.z = v[8 * j + 4 * hq + 2] * rstd * gg.z; y.w = v[8 * j + 4 * hq + 3] * rstd * gg.w;
                *(f32x4*)(dst + k) = y;
            }
    }
}
__device__ __forceinline__ void final_copy(const float* tmp, float* out_hi, int gtid, int nthr) {
    const f32x4* s = (const f32x4*)tmp; f32x4* d = (f32x4*)out_hi;
    for (int i = gtid; i < 16384 * 256; i += nthr) d[i] = s[i];
}

__device__ __forceinline__ void transpose_item(const float* W, int K, int N, bf16_t* WT, LAS float* scr, int item, int lane) {
    const int nblk = N / 32, kb = item / nblk, nb = item % nblk, k0 = 64 * kb, n0 = 32 * nb;
#pragma unroll 8
    for (int i = 0; i < 32; ++i) { const int kk = 2 * i + (lane >> 5); scr[kk * 33 + (lane & 31)] = W[(size_t)(k0 + kk) * N + n0 + (lane & 31)]; }
    asm volatile("s_waitcnt lgkmcnt(0)" ::: "memory");
    const int c = lane & 7;
#pragma unroll
    for (int j = 0; j < 4; ++j) {
        const int n = (lane >> 3) + 8 * j; const LAS float* s = scr + (8 * c) * 33 + n;
        u32x4 o; o.x = pk2(s[0 * 33], s[1 * 33]); o.y = pk2(s[2 * 33], s[3 * 33]); o.z = pk2(s[4 * 33], s[5 * 33]); o.w = pk2(s[6 * 33], s[7 * 33]);
        *(u32x4*)(WT + (size_t)(n0 + n) * K + k0 + 8 * c) = o;
    }
    asm volatile("s_waitcnt lgkmcnt(0)" ::: "memory");
}
#define XB_TMO      128
#define XB_XCNT(j)  (256  + 64 * (j))
#define XB_XSUB(j)  (1280 + 64 * (j))
#define XB_XGEN(j)  (2304 + 64 * (j))
#define XB_TOP      3328
#define XB_TOPGEN   3392
#define XCD_BAR_WORDS 3456
#define XB_SPIN_CAP (1u << 18)

__device__ __forceinline__ unsigned xb_ld(unsigned* p)              { return __hip_atomic_load(p, __ATOMIC_RELAXED, __HIP_MEMORY_SCOPE_AGENT); }
__device__ __forceinline__ unsigned xb_add(unsigned* p, unsigned v) { return __hip_atomic_fetch_add(p, v, __ATOMIC_RELAXED, __HIP_MEMORY_SCOPE_AGENT); }
__device__ __forceinline__ unsigned xb_xcc_id() { return (unsigned)__builtin_amdgcn_s_getreg((3 << 11) | 20) & 0xFu; }
#define XB_SPIN(cond, bar) do { unsigned _sp = 0; while (cond) { __builtin_amdgcn_s_sleep(1); \
    if ((++_sp & 255u) == 0u) { if (xb_ld(&(bar)[XB_TMO])) break; if (_sp > XB_SPIN_CAP) { atomicAdd(&(bar)[XB_TMO], 1u); break; } } } } while (0)

struct XcdBarrier {
    unsigned* bar; unsigned x;
    volatile LAS unsigned* st;
};

__device__ __forceinline__ XcdBarrier xcd_barrier_post(unsigned* bar, volatile LAS unsigned* st) {
    XcdBarrier b; b.bar = bar; b.x = xb_xcc_id(); b.st = st;
    if (threadIdx.x == 0) (void)xb_add(&bar[XB_XCNT(b.x)], 1u);
    return b;
}
__device__ __forceinline__ void xcd_barrier_complete(unsigned* bar, unsigned x, unsigned& nloc, unsigned& nx) {
    const unsigned G = gridDim.x * gridDim.y * gridDim.z;
    unsigned sum, cnt, mine, sp = 0u;
    for (;;) {
        sum = 0u; cnt = 0u; mine = 0u;
#pragma unroll 1
        for (unsigned j = 0; j < 16; ++j) { const unsigned c = xb_ld(&bar[XB_XCNT(j)]); sum += c; cnt += (c > 0u) ? 1u : 0u; mine = (j == x) ? c : mine; }
        if (sum == G) break;
        __builtin_amdgcn_s_sleep(1);
        if ((++sp & 255u) == 0u) { if (xb_ld(&bar[XB_TMO])) break; if (sp > XB_SPIN_CAP) { atomicAdd(&bar[XB_TMO], 1u); break; } }
    }
    nloc = mine > 0u ? mine : 1u; nx = cnt > 0u ? cnt : 1u;
}

__device__ __forceinline__ void xcd_barrier(const XcdBarrier& b) {
    asm volatile("s_waitcnt vmcnt(0)" ::: "memory");
    __syncthreads();
    if (threadIdx.x == 0) {
        unsigned* bar = b.bar;
        __builtin_amdgcn_s_waitcnt(0);
        unsigned nloc = b.st[0], nx = b.st[1];
        if (nloc == 0u) { xcd_barrier_complete(bar, b.x, nloc, nx); b.st[0] = nloc; b.st[1] = nx; }
        const unsigned old = xb_add(&bar[XB_XSUB(b.x)], 1u);
        const unsigned gen = old / nloc;
        if (old + 1u == (gen + 1u) * nloc) {
            __builtin_amdgcn_fence(__ATOMIC_RELEASE, "agent");
            asm volatile("s_waitcnt vmcnt(0)" ::: "memory");
            const unsigned og = xb_add(&bar[XB_TOP], 1u);
            const unsigned tg = og / nx;
            if (og + 1u == (tg + 1u) * nx) xb_add(&bar[XB_TOPGEN], 1u);
            else XB_SPIN(xb_ld(&bar[XB_TOPGEN]) == tg, bar);
            __builtin_amdgcn_fence(__ATOMIC_ACQUIRE, "agent");
            xb_add(&bar[XB_XGEN(b.x)], 1u);
            asm volatile("s_waitcnt vmcnt(0)" ::: "memory");
        } else {
            XB_SPIN(xb_ld(&bar[XB_XGEN(b.x)]) == gen, bar);
            __builtin_amdgcn_fence(__ATOMIC_ACQUIRE, "agent");
            asm volatile("s_waitcnt vmcnt(0)" ::: "memory");
        }
    }
    __syncthreads();
}

struct KArgs { const float* in[38]; float* out; unsigned char* ws; int ph_lo, ph_hi; };
typedef const __attribute__((address_space(4))) KArgs& KArgsR;
typedef const __attribute__((address_space(4))) KArgs* KArgsP;
__device__ __forceinline__ KArgsP opaque_kargs(KArgsP p) {
    const unsigned long long v = (unsigned long long)p; unsigned lo = (unsigned)v, hi = (unsigned)(v >> 32);
    asm volatile("" : "+s"(lo), "+s"(hi));
    lo = __builtin_amdgcn_readfirstlane(lo); hi = __builtin_amdgcn_readfirstlane(hi);
    return (KArgsP)(((unsigned long long)hi << 32) | lo);
}

__device__ __forceinline__ void p0_phase(KArgsR a, LAS unsigned char* lds, int tid, int lane, int wid) {
    const int G = gridDim.x, bid = blockIdx.x;
    const int gw = bid * 8 + wid, ngw = G * 8;
    {
        LAS float* sl = (LAS float*)(lds + 69632);
        LAS float* red = (LAS float*)(lds + 90112);
        const float* c = a.in[1]; const float* cctx = a.in[3]; const float* ada_w = a.in[4]; const float* ada_b = a.in[5];
        float* MODS = (float*)(a.ws + WS_MODS);
        for (int idx = tid; idx < 5 * 1024; idx += NTHR) { const int s = idx >> 10, k = idx & 1023; const float x = s < 4 ? c[s * 1024 + k] : cctx[k]; sl[idx] = x / (1.0f + __expf(-x)); }
        __syncthreads();
        for (int item = bid; item < 768; item += G) {
            const int i = item / 192, cgp = item % 192, hk = lane >> 5, cl = lane & 31;
            const float* W = ada_w + (size_t)i * 1024 * 6144 + cgp * 32 + cl;
            float acc[5] = {0.f, 0.f, 0.f, 0.f, 0.f};
            const int k0 = wid * 128 + hk;
#pragma unroll 8
            for (int kk = 0; kk < 64; ++kk) {
                const float w = W[(size_t)(k0 + 2 * kk) * 6144];
#pragma unroll
                for (int s = 0; s < 5; ++s) acc[s] += sl[s * 1024 + k0 + 2 * kk] * w;
            }
#pragma unroll
            for (int s = 0; s < 5; ++s) red[((wid * 2 + hk) * 5 + s) * 32 + cl] = acc[s];
            __syncthreads();
            if (tid < 160) {
                const int s = tid >> 5, l = tid & 31; float sum = ada_b[i * 6144 + cgp * 32 + l];
#pragma unroll
                for (int w = 0; w < 16; ++w) sum += red[(w * 5 + s) * 32 + l];
                MODS[(size_t)(i * 5 + s) * 6144 + cgp * 32 + l] = sum;
            }
            __syncthreads();
        }
    }
    {
        LAS float* scr = (LAS float*)(lds + wid * 8448);
        bf16_t* WB = (bf16_t*)(a.ws + WS_WB);
        for (int mi = 0; mi < 16; ++mi) {
            const float* W; int K, N; bf16_t* WT;
            if (mi < 4)       { W = a.in[8]  + (size_t)mi * 1024 * 4096;        K = 1024; N = 4096; WT = WB + WB_W1 + (size_t)mi * 4096 * 1024; }
            else if (mi < 8)  { W = a.in[9]  + (size_t)(mi - 4) * 4096 * 1024;  K = 4096; N = 1024; WT = WB + WB_W2 + (size_t)(mi - 4) * 4096 * 1024; }
            else if (mi < 10) { W = a.in[11] + (size_t)(mi - 8) * 1024 * 3072;  K = 1024; N = 3072; WT = WB + WB_EVIN + (size_t)(mi - 8) * 3072 * 1024; }
            else if (mi < 12) { W = a.in[12] + (size_t)(mi - 10) * 1024 * 1024; K = 1024; N = 1024; WT = WB + WB_EVOUT + (size_t)(mi - 10) * 1024 * 1024; }
            else if (mi < 14) { W = a.in[29] + (size_t)(mi - 12) * 1024 * 2560; K = 1024; N = 2560; WT = WB + WB_ODIN + (size_t)(mi - 12) * 2560 * 1024; }
            else              { W = a.in[30] + (size_t)(mi - 14) * 1280 * 1024; K = 1280; N = 1024; WT = WB + WB_ODOUT + (size_t)(mi - 14) * 1024 * 1280; }
            const int nit = (K / 64) * (N / 32);
            for (int it = gw; it < nit; it += ngw) transpose_item(W, K, N, WT, scr, it, lane);
        }
    }
    {
        bf16_t* WSC = (bf16_t*)(a.ws + WS_WSC);
        for (int it = bid; it < 128; it += G) {
            const int mat = it & 1, jdn = it >> 1;
            const float* W = (mat ? a.in[35] : a.in[33]) + (size_t)jdn * 6400;
            bf16_t* O = WSC + (size_t)it * 7680;
            for (int idx = tid; idx < 7680; idx += NTHR) { const int dp = idx / 96, c = idx % 96; O[idx] = (bf16_t)f2bf(c < 80 ? W[c * 80 + dp] : 0.f); }
        }
    }
    {
        _Float16* H2 = (_Float16*)(a.ws + WS_H2);
        for (int rowi = gw; rowi < 2 * 8448; rowi += ngw) {
            const int j = rowi / 8448, p = rowi % 8448;
            const float* w1 = a.in[15] + j * 33 * 64; const float* b1 = a.in[16] + j * 64; const float* w2 = a.in[17] + j * 64 * 64; const float* b2 = a.in[18] + j * 64;
            const float fq = a.in[21][j * 64 + lane];
            int pp, L; if (p < 8192) { pp = p; L = 8192; } else { pp = p - 8192; L = 256; }
            const float invL = 1.0f / (float)L;
            const float t = (float)pp * invL;
            float z = b1[lane] + t * w1[lane];
#pragma unroll 4
            for (int n = 1; n <= 16; ++n) {
                const float rv = (float)((pp * n) & (L - 1)) * invL;
                z += cos_rev(rv) * w1[n * 64 + lane] + sin_rev(rv) * w1[(16 + n) * 64 + lane];
            }
            const float h1 = fsin(fq * z);
            float z2 = b2[lane];
#pragma unroll 8
            for (int k = 0; k < 64; ++k) z2 += __builtin_bit_cast(float, __builtin_amdgcn_readlane(__builtin_bit_cast(int, h1), k)) * w2[k * 64 + lane];
            H2[(size_t)rowi * 64 + lane] = (_Float16)fsin(fq * z2);
        }
    }
}

__device__ __forceinline__ cf2 cmul(cf2 a, cf2 b) { return MKCF(a.x * b.x - a.y * b.y, a.x * b.y + a.y * b.x); }
template <bool UZ> __device__ __forceinline__ void fft_fwd_t(LAS cf2* X, int tid) {
#pragma unroll 1
    for (int s = 0; s < 7; ++s) {
        const int lq = 12 - 2 * s, q = 1 << lq;
        const float rs = __builtin_bit_cast(float, (unsigned)(127 - (lq + 2)) << 23);
        if (lq > 9) {
#pragma unroll 2
            for (int i = 0; i < 8; ++i) {
                const int bf = tid + NTHR * i, j = bf & (q - 1), i0 = ((bf >> lq) << (lq + 2)) + j;
                const bool z = UZ && (s == 0);
                const cf2 x0 = X[i0], x1 = X[i0 + q], x2 = z ? MKCF(0.f, 0.f) : X[i0 + 2 * q], x3 = z ? MKCF(0.f, 0.f) : X[i0 + 3 * q];
                const float rv = (float)j * rs;
                const cf2 w1 = MKCF(cos_rev(rv), -sin_rev(rv)), w2 = cmul(w1, w1), w3 = cmul(w2, w1);
                const cf2 A = MKCF(x0.x + x2.x, x0.y + x2.y), B = MKCF(x0.x - x2.x, x0.y - x2.y), C = MKCF(x1.x + x3.x, x1.y + x3.y), D = MKCF(x1.x - x3.x, x1.y - x3.y);
                X[i0] = MKCF(A.x + C.x, A.y + C.y);
                X[i0 + q] = cmul(MKCF(B.x + D.y, B.y - D.x), w1);
                X[i0 + 2 * q] = cmul(MKCF(A.x - C.x, A.y - C.y), w2);
                X[i0 + 3 * q] = cmul(MKCF(B.x - D.y, B.y + D.x), w3);
            }
        } else {
            const int j = tid & (q - 1);
            const float rv = (float)j * rs;
            const cf2 w1 = MKCF(cos_rev(rv), -sin_rev(rv)), w2 = cmul(w1, w1), w3 = cmul(w2, w1);
#pragma unroll 4
            for (int i = 0; i < 8; ++i) {
                const int bf = tid + NTHR * i, i0 = ((bf >> lq) << (lq + 2)) + j;
                const cf2 x0 = X[i0], x1 = X[i0 + q], x2 = X[i0 + 2 * q], x3 = X[i0 + 3 * q];
                const cf2 A = MKCF(x0.x + x2.x, x0.y + x2.y), B = MKCF(x0.x - x2.x, x0.y - x2.y), C = MKCF(x1.x + x3.x, x1.y + x3.y), D = MKCF(x1.x - x3.x, x1.y - x3.y);
                X[i0] = MKCF(A.x + C.x, A.y + C.y);
                X[i0 + q] = cmul(MKCF(B.x + D.y, B.y - D.x), w1);
                X[i0 + 2 * q] = cmul(MKCF(A.x - C.x, A.y - C.y), w2);
                X[i0 + 3 * q] = cmul(MKCF(B.x - D.y, B.y + D.x), w3);
            }
        }
        __syncthreads();
    }
}
__device__ __forceinline__ void fft_fwd(LAS cf2* X, int tid) { fft_fwd_t<false>(X, tid); }
template <bool LH> __device__ __forceinline__ void fft_inv_t(LAS cf2* X, int tid) {
#pragma unroll 1
    for (int s = 6; s >= 0; --s) {
        const int lq = 12 - 2 * s, q = 1 << lq;
        const float rs = __builtin_bit_cast(float, (unsigned)(127 - (lq + 2)) << 23);
        if (lq > 9) {
#pragma unroll 2
            for (int i = 0; i < 8; ++i) {
                const int bf = tid + NTHR * i, j = bf & (q - 1), i0 = ((bf >> lq) << (lq + 2)) + j;
                const float rv = (float)j * rs;
                const cf2 w1 = MKCF(cos_rev(rv), sin_rev(rv)), w2 = cmul(w1, w1), w3 = cmul(w2, w1);
                const cf2 u0 = X[i0], u1 = cmul(X[i0 + q], w1), u2 = cmul(X[i0 + 2 * q], w2), u3 = cmul(X[i0 + 3 * q], w3);
                const cf2 A = MKCF(u0.x + u2.x, u0.y + u2.y), B = MKCF(u0.x - u2.x, u0.y - u2.y), C = MKCF(u1.x + u3.x, u1.y + u3.y), D = MKCF(u1.x - u3.x, u1.y - u3.y);
                X[i0] = MKCF(A.x + C.x, A.y + C.y);
                X[i0 + q] = MKCF(B.x - D.y, B.y + D.x);
                if (!(LH && s == 0)) {
                    X[i0 + 2 * q] = MKCF(A.x - C.x, A.y - C.y);
                    X[i0 + 3 * q] = MKCF(B.x + D.y, B.y - D.x);
                }
            }
        } else {
            const int j = tid & (q - 1);
            const float rv = (float)j * rs;
            const cf2 w1 = MKCF(cos_rev(rv), sin_rev(rv)), w2 = cmul(w1, w1), w3 = cmul(w2, w1);
#pragma unroll 4
            for (int i = 0; i < 8; ++i) {
                const int bf = tid + NTHR * i, i0 = ((bf >> lq) << (lq + 2)) + j;
                const cf2 u0 = X[i0], u1 = cmul(X[i0 + q], w1), u2 = cmul(X[i0 + 2 * q], w2), u3 = cmul(X[i0 + 3 * q], w3);
                const cf2 A = MKCF(u0.x + u2.x, u0.y + u2.y), B = MKCF(u0.x - u2.x, u0.y - u2.y), C = MKCF(u1.x + u3.x, u1.y + u3.y), D = MKCF(u1.x - u3.x, u1.y - u3.y);
                X[i0] = MKCF(A.x + C.x, A.y + C.y);
                X[i0 + q] = MKCF(B.x - D.y, B.y + D.x);
                X[i0 + 2 * q] = MKCF(A.x - C.x, A.y - C.y);
                X[i0 + 3 * q] = MKCF(B.x + D.y, B.y - D.x);
            }
        }
        __syncthreads();
    }
}
__device__ __forceinline__ void fft_inv(LAS cf2* X, int tid) { fft_inv_t<false>(X, tid); }
__device__ __forceinline__ void mul_spectrum(LAS cf2* X, const unsigned* KH, float bias, int tid) {
#pragma unroll 4
    for (int i = 0; i < 32; ++i) {
        const int p = tid + NTHR * i;
        const h16x2 kh = __builtin_bit_cast(h16x2, KH[p]);
        X[p] = cmul(X[p], MKCF((float)kh.x + bias, (float)kh.y));
    }
    __syncthreads();
}

typedef _Float16 f16x8 __attribute__((ext_vector_type(8)));
__device__ __forceinline__ int rev4_14(int x) { const unsigned r = __builtin_bitreverse32((unsigned)x) >> 18; return (int)(((r & 0x2AAAu) >> 1) | ((r & 0x1555u) << 1)); }
__device__ __forceinline__ void khat_item(KArgsR a, LAS unsigned char* lds, int j, int c, int tid) {
    LAS cf2* X = (LAS cf2*)lds; LAS float* Xf = (LAS float*)lds;
    const int lane = tid & 63, wid = tid >> 6, r = lane & 31, h = lane >> 5;
    const float* w3 = a.in[19] + (size_t)j * 64 * 2048; const float* b3 = a.in[20] + j * 2048; const float* decay = a.in[22] + (size_t)j * 2048;
    const _Float16* H2 = (const _Float16*)(a.ws + WS_H2) + (size_t)j * 8448 * 64;
    unsigned* KH = (unsigned*)(a.ws + WS_BIG + BIG_KH);
    const int o = (r >> 1) & 1, dir = r & 1;
    const int col = o * 1024 + dir * 512 + c;
    f16x8 bfr[4];
#pragma unroll
    for (int ks = 0; ks < 4; ++ks)
#pragma unroll
        for (int jj = 0; jj < 8; ++jj) bfr[ks][jj] = (r < 4) ? (_Float16)w3[(size_t)(16 * ks + 8 * h + jj) * 2048 + col] : (_Float16)0.f;
    const float bb = b3[col], dsc = fabsf(decay[col]) * (1.4426950408889634f / 8192.0f);
    if (tid == 0) X[8192] = MKCF(0.f, 0.f);
#pragma unroll 4
    for (int ti = 0; ti < 32; ++ti) {
        const int tl = wid + 8 * ti;
        f32x16 acc;
#pragma unroll
        for (int i = 0; i < 16; ++i) acc[i] = 0.f;
#pragma unroll
        for (int ks = 0; ks < 4; ++ks) {
            const f16x8 af = *(const f16x8*)(H2 + (size_t)(32 * tl + r) * 64 + 16 * ks + 8 * h);
            acc = __builtin_amdgcn_mfma_f32_32x32x16_f16(af, bfr[ks], acc, 0, 0, 0);
        }
        if (r < 4) {
#pragma unroll
            for (int i = 0; i < 16; ++i) {
                const int p = 32 * tl + (i & 3) + 8 * (i >> 2) + 4 * h;
                const float val = (acc[i] + bb) * __builtin_amdgcn_exp2f(-(float)p * dsc);
                if (dir == 0) Xf[2 * p + o] = val;
                else if (p != 0) Xf[2 * (16384 - p) + o] = val;
            }
        }
    }
    __syncthreads();
    fft_fwd(X, tid);
#pragma unroll 4
    for (int i = 0; i < 32; ++i) {
        const int p = tid + NTHR * i;
        const int k = rev4_14(p), pm = rev4_14((16384 - k) & 16383);
        const cf2 z = X[p], zm = X[pm];
        h16x2 k0, k1;
        k0.x = (_Float16)(0.5f * (z.x + zm.x)); k0.y = (_Float16)(0.5f * (z.y - zm.y));
        k1.x = (_Float16)(0.5f * (z.y + zm.y)); k1.y = (_Float16)(0.5f * (zm.x - z.x));
        KH[(size_t)c * 16384 + p] = __builtin_bit_cast(unsigned, k0);
        KH[(size_t)(512 + c) * 16384 + p] = __builtin_bit_cast(unsigned, k1);
    }
    __syncthreads();
}

__device__ __forceinline__ float conv3_at(const bf16_t* p, int t, float w0, float w1, float w2, float bs) {
    const float l = t > 0 ? bf2f(p[t - 1]) : 0.f, m = bf2f(p[t]), r = t < 8191 ? bf2f(p[t + 1]) : 0.f;
    return w0 * l + w1 * m + w2 * r + bs;
}
__device__ __forceinline__ void conv3_pair(const bf16_t* p, int t2, float w0, float w1, float w2, float bs, float (&o)[2]) {
    const unsigned wm = *(const unsigned*)(p + t2);
    const unsigned wl = t2 > 0 ? *(const unsigned*)(p + t2 - 2) : 0u, wr = t2 < 8190 ? *(const unsigned*)(p + t2 + 2) : 0u;
    const float xm1 = __builtin_bit_cast(float, wl & 0xffff0000u), x0 = __builtin_bit_cast(float, wm << 16), x1 = __builtin_bit_cast(float, wm & 0xffff0000u), x2 = __builtin_bit_cast(float, wr << 16);
    o[0] = w0 * xm1 + w1 * x0 + w2 * x1 + bs; o[1] = w0 * x0 + w1 * x1 + w2 * x2 + bs;
}
__device__ __forceinline__ void hyena_lat_item(KArgsR a, LAS unsigned char* lds, int j, int c, int pair, int tid) {
    LAS cf2* X = (LAS cf2*)lds;
    const bf16_t* UT = (const bf16_t*)(a.ws + WS_BIG + BIG_U);
    const unsigned* KH = (const unsigned*)(a.ws + WS_BIG + BIG_KH);
    bf16_t* ACT = (bf16_t*)(a.ws + WS_ACT);
    const float* sw = a.in[13] + (size_t)j * 3 * 1536; const float* sb = a.in[14] + j * 1536; const float* hbias = a.in[23] + j * 1024;
    const int b0 = 2 * pair;
    const bf16_t* V0 = UT + ((size_t)b0 * 1536 + c) * 8192; const bf16_t* V1 = V0 + (size_t)1536 * 8192;
    const float wv0 = sw[c], wv1 = sw[1536 + c], wv2 = sw[3072 + c], bv = sb[c];
    const float wa0 = sw[512 + c], wa1 = sw[1536 + 512 + c], wa2 = sw[3072 + 512 + c], ba_ = sb[512 + c];
    const float wb0 = sw[1024 + c], wb1 = sw[1536 + 1024 + c], wb2 = sw[3072 + 1024 + c], bb_ = sb[1024 + c];
    const float bias0 = hbias[c], bias1 = hbias[512 + c];
#pragma unroll 4
    for (int i = 0; i < 8; ++i) {
        const int t2 = 2 * tid + 1024 * i;
        const unsigned w0 = *(const unsigned*)(V0 + t2), w1 = *(const unsigned*)(V1 + t2);
        f32x4 o; o.x = __builtin_bit_cast(float, w0 << 16); o.y = __builtin_bit_cast(float, w1 << 16); o.z = __builtin_bit_cast(float, w0 & 0xffff0000u); o.w = __builtin_bit_cast(float, w1 & 0xffff0000u);
        *(LAS f32x4*)(X + t2) = o;
    }
    __syncthreads();
#pragma unroll 2
    for (int i = 0; i < 16; ++i) {
        const int t = tid + NTHR * i;
        const cf2 l = t > 0 ? X[t - 1] : MKCF(0.f, 0.f), m = X[t], r = t < 8191 ? X[t + 1] : MKCF(0.f, 0.f);
        X[8192 + t] = MKCF(wv0 * l.x + wv1 * m.x + wv2 * r.x + bv, wv0 * l.y + wv1 * m.y + wv2 * r.y + bv);
    }
    __syncthreads();
#pragma unroll 2
    for (int i = 0; i < 16; ++i) { const int t = tid + NTHR * i; X[t] = X[8192 + t]; }
    __syncthreads();
    fft_fwd_t<true>(X, tid);
    mul_spectrum(X, KH + (size_t)c * 16384, bias0, tid);
    fft_inv_t<true>(X, tid);
    {
        const bf16_t* A0 = V0 + (size_t)512 * 8192; const bf16_t* A1 = V1 + (size_t)512 * 8192;
#pragma unroll 2
        for (int i = 0; i < 8; ++i) {
            const int t2 = 2 * tid + 1024 * i;
            float xa[2], xb[2];
            conv3_pair(A0, t2, wa0, wa1, wa2, ba_, xa); conv3_pair(A1, t2, wa0, wa1, wa2, ba_, xb);
            const f32x4 y = *(const LAS f32x4*)(X + t2);
            f32x4 o; o.x = xa[0] * y.x * (1.0f / 16384.0f); o.y = xb[0] * y.y * (1.0f / 16384.0f); o.z = xa[1] * y.z * (1.0f / 16384.0f); o.w = xb[1] * y.w * (1.0f / 16384.0f);
            *(LAS f32x4*)(X + t2) = o;
        }
    }
    __syncthreads();
    fft_fwd_t<true>(X, tid);
    mul_spectrum(X, KH + (size_t)(512 + c) * 16384, bias1, tid);
    fft_inv_t<true>(X, tid);
    {
        const bf16_t* B0 = V0 + (size_t)1024 * 8192; const bf16_t* B1 = V1 + (size_t)1024 * 8192;
#pragma unroll 2
        for (int i = 0; i < 8; ++i) {
            const int t2 = 2 * tid + 1024 * i;
            float xa[2], xb[2];
            conv3_pair(B0, t2, wb0, wb1, wb2, bb_, xa); conv3_pair(B1, t2, wb0, wb1, wb2, bb_, xb);
            const f32x4 y = *(const LAS f32x4*)(X + t2);
            ACT[(size_t)(b0 * 8192 + t2) * 1024 + c] = (bf16_t)f2bf(xa[0] * y.x * (1.0f / 16384.0f));
            ACT[(size_t)((b0 + 1) * 8192 + t2) * 1024 + c] = (bf16_t)f2bf(xb[0] * y.y * (1.0f / 16384.0f));
            ACT[(size_t)(b0 * 8192 + t2 + 1) * 1024 + c] = (bf16_t)f2bf(xa[1] * y.z * (1.0f / 16384.0f));
            ACT[(size_t)((b0 + 1) * 8192 + t2 + 1) * 1024 + c] = (bf16_t)f2bf(xb[1] * y.w * (1.0f / 16384.0f));
        }
    }
    __syncthreads();
}

__device__ __forceinline__ void hyena_ctx_item(KArgsR a, LAS unsigned char* lds, int j, int c, int tid) {
    LAS float* ks = (LAS float*)lds;
    LAS float* vc = ks + 1024;
    LAS float* zc = vc + 1024;
    LAS float* w3c = zc + 1024;
    const bf16_t* U = (const bf16_t*)(a.ws + WS_BIG + BIG_U);
    bf16_t* ACT = (bf16_t*)(a.ws + WS_ACT);
    const float* w3 = a.in[19] + (size_t)j * 64 * 2048; const float* b3 = a.in[20] + j * 2048; const float* decay = a.in[22] + (size_t)j * 2048;
    const _Float16* H2 = (const _Float16*)(a.ws + WS_H2) + ((size_t)j * 8448 + 8192) * 64;
    const float* sw = a.in[13] + (size_t)j * 3 * 1536; const float* sb = a.in[14] + j * 1536; const float* hbias = a.in[23] + j * 1024;
    if (tid < 256) w3c[tid] = w3[(size_t)(tid & 63) * 2048 + (tid >> 6) * 512 + c];
    if (tid < 2) ks[tid * 512] = 0.f;
    __syncthreads();
    float x1c[2], x2c[2];
#pragma unroll
    for (int k = 0; k < 2; ++k) {
        const int idx = tid + NTHR * k;
        {
            const int od = idx >> 8, p = idx & 255, col = od * 512 + c, o = od >> 1, dir = od & 1;
            const f16x8* hr = (const f16x8*)(H2 + (size_t)p * 64); float dot = 0.f;
#pragma unroll
            for (int u8 = 0; u8 < 8; ++u8) { const f16x8 hv = hr[u8];
#pragma unroll
                for (int e = 0; e < 8; ++e) dot += (float)hv[e] * w3c[od * 64 + u8 * 8 + e]; }
            const float val = (dot + b3[col]) * __expf(-(float)p * (1.0f / 256.0f) * fabsf(decay[col]));
            if (dir == 0) ks[o * 512 + 256 + p] = val; else if (p != 0) ks[o * 512 + 256 - p] = val;
        }
        {
            const int b = idx >> 8, t = idx & 255;
            float cv[3];
#pragma unroll
            for (int g = 0; g < 3; ++g) {
                const int ch = g * 512 + c;
                const bf16_t* Ur = U + (size_t)4 * 1536 * 8192 + ((size_t)b * 1536 + ch) * 256 + t;
                const float l = t > 0 ? bf2f(Ur[-1]) : 0.f, m = bf2f(Ur[0]), r = t < 255 ? bf2f(Ur[1]) : 0.f;
                cv[g] = sw[ch] * l + sw[1536 + ch] * m + sw[3072 + ch] * r + sb[ch];
            }
            vc[idx] = cv[0]; x1c[k] = cv[1]; x2c[k] = cv[2];
        }
    }
    __syncthreads();
    const float bias0 = hbias[c], bias1 = hbias[512 + c];
#pragma unroll
    for (int k = 0; k < 2; ++k) {
        const int idx = tid + NTHR * k, b = idx >> 8, t = idx & 255;
        float y = 0.f;
        const LAS float* kp = ks + 256 + t; const LAS f32x4* vp = (const LAS f32x4*)(vc + b * 256);
#pragma unroll 4
        for (int s4 = 0; s4 < 64; ++s4) { const f32x4 v = vp[s4]; y += kp[-4 * s4] * v.x + kp[-4 * s4 - 1] * v.y + kp[-4 * s4 - 2] * v.z + kp[-4 * s4 - 3] * v.w; }
        zc[idx] = x1c[k] * (y + vc[idx] * bias0);
    }
    __syncthreads();
#pragma unroll
    for (int k = 0; k < 2; ++k) {
        const int idx = tid + NTHR * k, b = idx >> 8, t = idx & 255;
        float y = 0.f;
        const LAS float* kp = ks + 512 + 256 + t; const LAS f32x4* vp = (const LAS f32x4*)(zc + b * 256);
#pragma unroll 4
        for (int s4 = 0; s4 < 64; ++s4) { const f32x4 v = vp[s4]; y += kp[-4 * s4] * v.x + kp[-4 * s4 - 1] * v.y + kp[-4 * s4 - 2] * v.z + kp[-4 * s4 - 3] * v.w; }
        ACT[(size_t)(ML + b * 256 + t) * 1024 + c] = (bf16_t)f2bf(x2c[k] * (y + zc[idx] * bias1));
    }
    __syncthreads();
}

#define MFMA32(a_, b_, c_) __builtin_amdgcn_mfma_f32_32x32x16_bf16((a_), (b_), (c_), 0, 0, 0)
#define MFMA16(a_, b_, c_) __builtin_amdgcn_mfma_f32_16x16x32_bf16((a_), (b_), (c_), 0, 0, 0)
__device__ __forceinline__ void attn_unit(KArgsR a, LAS unsigned char* lds, int b, int hh, int qrow0, int kt_lo, int kt_hi, float lam, float osc, const float* subg, int tid) {
    const int lane = tid & 63, wid = tid >> 6, r = lane & 31, h = lane >> 5;
    const bf16_t* Qb = (const bf16_t*)(a.ws + WS_BIG + BIG_Q); const bf16_t* Kb = (const bf16_t*)(a.ws + WS_BIG + BIG_K); const bf16_t* VT = (const bf16_t*)(a.ws + WS_BIG + BIG_VT);
    bf16_t* ACT = (bf16_t*)(a.ws + WS_ACT);
    const int qrow = qrow0 + wid * 32 + r;
    LAS unsigned* osl = (LAS unsigned*)(lds + 53248) + wid * 2048 + lane;
    const int kkey = tid >> 3, kch = tid & 7;
    const bf16_t* vbase = VT + (size_t)((b * 4 + hh) * 128) * NKEY + (size_t)(tid >> 3) * NKEY + (tid & 7) * 8;
#define ATT_LOAD(KR, V0, V1, kt_) do { const int ktt_ = (kt_); const int kb_ = ktt_ < 128 ? b * 8192 + ktt_ * 64 : ML + b * 256 + (ktt_ - 128) * 64; \
        KR = *(const u32x4*)(kcol + (size_t)(kb_ + kkey) * 512); V0 = *(const u32x4*)(vbase + ktt_ * 64); V1 = *(const u32x4*)(vbase + (size_t)64 * NKEY + ktt_ * 64); } while (0)
#define ATT_STORE(KR, V0, V1, slot_) do { LAS unsigned char* ks_ = lds + (slot_) * 26624; LAS unsigned char* vs_ = ks_ + 9216 + (tid >> 3) * 136 + (tid & 7) * 16; \
        *(LAS u32x4*)(ks_ + kkey * 144 + kch * 16) = KR; \
        { u32x2 w0_, w1_; w0_.x = V0.x; w0_.y = V0.y; w1_.x = V0.z; w1_.y = V0.w; *(LAS u32x2*)(vs_) = w0_; *(LAS u32x2*)(vs_ + 8) = w1_; } \
        { u32x2 w0_, w1_; w0_.x = V1.x; w0_.y = V1.y; w1_.x = V1.z; w1_.y = V1.w; *(LAS u32x2*)(vs_ + 64 * 136) = w0_; *(LAS u32x2*)(vs_ + 64 * 136 + 8) = w1_; } } while (0)
#pragma unroll 1
    for (int jj = 0; jj < 2; ++jj) {
        const bf16_t* kcol = Kb + hh * 128 + jj * 64 + kch * 8;
        bf16x8 qf[4];
#pragma unroll
        for (int ks = 0; ks < 4; ++ks) qf[ks] = *(const bf16x8*)(Qb + (size_t)qrow * 512 + hh * 128 + jj * 64 + ks * 16 + h * 8);
        f32x16 o[4];
#pragma unroll
        for (int et = 0; et < 4; ++et)
#pragma unroll
            for (int i = 0; i < 16; ++i) o[et][i] = 0.f;
        float mrun = -INFINITY, lrun = 0.f;
        u32x4 kA, vA0, vA1, kB, vB0, vB1;
        ATT_LOAD(kA, vA0, vA1, kt_lo); ATT_LOAD(kB, vB0, vB1, kt_lo + 1);
        ATT_STORE(kA, vA0, vA1, 0);
        if (kt_lo + 2 < kt_hi) ATT_LOAD(kA, vA0, vA1, kt_lo + 2);
#pragma unroll 1
        for (int kt2 = kt_lo; kt2 < kt_hi; kt2 += 2) {
#pragma unroll
            for (int par = 0; par < 2; ++par) {
                __syncthreads();
                if (par == 0) { ATT_STORE(kB, vB0, vB1, 1); if (kt2 + 3 < kt_hi) ATT_LOAD(kB, vB0, vB1, kt2 + 3); }
                else { if (kt2 + 2 < kt_hi) { ATT_STORE(kA, vA0, vA1, 0); } if (kt2 + 4 < kt_hi) ATT_LOAD(kA, vA0, vA1, kt2 + 4); }
                const LAS unsigned char* Kl = lds + par * 26624; const LAS unsigned char* Vl = Kl + 9216;
                f32x16 s0, s1;
#pragma unroll
                for (int i = 0; i < 16; ++i) { s0[i] = 0.f; s1[i] = 0.f; }
#pragma unroll
                for (int ks = 0; ks < 4; ++ks) {
                    const bf16x8 k0 = *(const LAS bf16x8*)(Kl + r * 144 + (ks * 16 + h * 8) * 2);
                    const bf16x8 k1 = *(const LAS bf16x8*)(Kl + (32 + r) * 144 + (ks * 16 + h * 8) * 2);
                    s0 = MFMA32(k0, qf[ks], s0); s1 = MFMA32(k1, qf[ks], s1);
                }
                float mx = s0[0];
#pragma unroll
                for (int i = 0; i < 16; ++i) { mx = fmaxf(mx, s0[i]); mx = fmaxf(mx, s1[i]); }
                mx = fmaxf(mx, shflx(mx, 32, lane));
                const float mnew = fmaxf(mrun, mx);
                const float alpha = __builtin_amdgcn_exp2f(mrun - mnew);
                float sum = 0.f;
#pragma unroll
                for (int i = 0; i < 16; ++i) { s0[i] = __builtin_amdgcn_exp2f(s0[i] - mnew); s1[i] = __builtin_amdgcn_exp2f(s1[i] - mnew); sum += s0[i] + s1[i]; }
                sum += shflx(sum, 32, lane);
                lrun = lrun * alpha + sum; mrun = mnew;
                if (__builtin_amdgcn_ballot_w64(alpha != 1.0f) != 0ull) {
#pragma unroll
                    for (int et = 0; et < 4; ++et)
#pragma unroll
                        for (int i = 0; i < 16; ++i) o[et][i] *= alpha;
                }
                __builtin_amdgcn_sched_barrier(0);
#pragma unroll
                for (int st = 0; st < 2; ++st)
#pragma unroll
                    for (int s = 0; s < 2; ++s) {
                        u32x4 pw;
                        if (st == 0) { pw.x = pk2(s0[8 * s + 0], s0[8 * s + 1]); pw.y = pk2(s0[8 * s + 2], s0[8 * s + 3]); pw.z = pk2(s0[8 * s + 4], s0[8 * s + 5]); pw.w = pk2(s0[8 * s + 6], s0[8 * s + 7]); }
                        else         { pw.x = pk2(s1[8 * s + 0], s1[8 * s + 1]); pw.y = pk2(s1[8 * s + 2], s1[8 * s + 3]); pw.z = pk2(s1[8 * s + 4], s1[8 * s + 5]); pw.w = pk2(s1[8 * s + 6], s1[8 * s + 7]); }
                        const bf16x8 pf = __builtin_bit_cast(bf16x8, pw);
                        u32x4 vw[4];
#pragma unroll
                        for (int et = 0; et < 4; ++et) {
                            const LAS unsigned char* vp = Vl + (32 * et + r) * 136 + (32 * st + 16 * s + 4 * h) * 2;
                            const u32x2 lo = *(const LAS u32x2*)vp, hi = *(const LAS u32x2*)(vp + 16);
                            vw[et].x = lo.x; vw[et].y = lo.y; vw[et].z = hi.x; vw[et].w = hi.y;
                        }
                        __builtin_amdgcn_s_setprio(1);
#pragma unroll
                        for (int et = 0; et < 4; ++et) o[et] = MFMA32(__builtin_bit_cast(bf16x8, vw[et]), pf, o[et]);
                        __builtin_amdgcn_s_setprio(0);
                        if (st * 2 + s == 1) __builtin_amdgcn_sched_barrier(0);
                    }
            }
        }
        const float inv = 1.0f / lrun;
        if (jj == 0) {
#pragma unroll
            for (int et = 0; et < 4; ++et)
#pragma unroll
                for (int i = 0; i < 8; ++i) osl[(et * 8 + i) * 64] = pk2(o[et][2 * i] * inv, o[et][2 * i + 1] * inv);
        } else {
            float ss = 0.f;
#pragma unroll
            for (int et = 0; et < 4; ++et)
#pragma unroll
                for (int i = 0; i < 16; ++i) { const unsigned pw0 = osl[(et * 8 + (i >> 1)) * 64]; const float p0 = __builtin_bit_cast(float, (i & 1) ? (pw0 & 0xffff0000u) : (pw0 << 16)); const float v = p0 - lam * (o[et][i] * inv); o[et][i] = v; ss += v * v; }
            ss += shflx(ss, 32, lane);
            const float rstd = rsqrtf(ss * (1.0f / 128.0f) + 1e-6f) * osc;
#pragma unroll
            for (int et = 0; et < 4; ++et)
#pragma unroll
                for (int g = 0; g < 4; ++g) {
                    const int e = 32 * et + 8 * g + 4 * h;
                    const f32x4 sg = *(const f32x4*)(subg + e);
                    u32x2 w; w.x = pk2(o[et][4 * g] * rstd * sg.x, o[et][4 * g + 1] * rstd * sg.y); w.y = pk2(o[et][4 * g + 2] * rstd * sg.z, o[et][4 * g + 3] * rstd * sg.w);
                    *(u32x2*)(ACT + (size_t)qrow * 1024 + 512 + hh * 128 + e) = w;
                }
        }
        __syncthreads();
    }
#undef ATT_LOAD
#undef ATT_STORE
}

__device__ __forceinline__ int scan_seq(int d, int k) { return d == 0 ? k : (k < 4 ? 3 - k : 135 - k); }
__device__ __forceinline__ float fsigm(float x) { return __builtin_amdgcn_rcpf(1.0f + __builtin_amdgcn_exp2f(-1.4426950408889634f * x)); }
__device__ __forceinline__ float fgelu(float g) { const float u = 0.7978845608028654f * (g + 0.044715f * g * g * g); return 0.5f * g * (2.0f - 2.0f * __builtin_amdgcn_rcpf(1.0f + __builtin_amdgcn_exp2f(2.8853900817779268f * u))); }
__device__ __forceinline__ void scan_chain(KArgsR a, LAS unsigned char* lds, int j, int cid, int tid) {
    const int d = tid >> 8, ht = tid & 255, lane = tid & 63, hw = (tid >> 6) & 3;
    const int q4 = cid & 3, n = (cid >> 2) & 15, b = cid >> 6;
    const int ch0 = n * 80, cq0 = ch0 + q4 * 20;
    LAS unsigned char* hb = lds + d * 69120;
    LAS float* xraw = (LAS float*)hb; LAS bf16_t* xcb = (LAS bf16_t*)(hb + 21504); LAS bf16_t* Wl = (LAS bf16_t*)(hb + 33792);
    LAS float* al = (LAS float*)(hb + 46080); LAS float* bl = (LAS float*)(hb + 54784); LAS float* hl = (LAS float*)(hb + 63488);
    const bf16_t* XG = (const bf16_t*)(a.ws + WS_BIG); bf16_t* ACT = (bf16_t*)(a.ws + WS_ACT);
    const bf16_t* WSC = (const bf16_t*)(a.ws + WS_WSC) + (size_t)(((j * 2 + d) * 16 + n) * 2) * 7680;
    const float* convw = a.in[31] + (size_t)j * 4 * 1280; const float* convb = a.in[32] + j * 1280;
    const float* ba = a.in[34] + j * 2560 + d * 1280; const float* bx = a.in[36] + j * 2560 + d * 1280; const float* lamp = a.in[37] + j * 2560 + d * 1280;
    for (int idx = ht; idx < 2 * 32 * 12; idx += 256) {
        const int mat = idx / 384, rem = idx % 384, dpl = rem / 12, ck = rem % 12;
        u32x4 v = {0u, 0u, 0u, 0u};
        if (dpl < 20) v = *(const u32x4*)(WSC + (size_t)mat * 7680 + (q4 * 20 + dpl) * 96 + ck * 8);
        *(LAS u32x4*)(Wl + mat * 3072 + dpl * 96 + ck * 8) = v;
    }
    for (int idx = ht; idx < 64 * 16; idx += 256) xcb[(idx >> 4) * 96 + 80 + (idx & 15)] = 0;
    float bav[2], bxv[2], spv[2]; bool val[2];
#pragma unroll
    for (int nt = 0; nt < 2; ++nt) {
        const int dp = 16 * nt + (lane & 15); val[nt] = dp < 20; const int gc = cq0 + (val[nt] ? dp : 0);
        bav[nt] = ba[gc]; bxv[nt] = bx[gc]; spv[nt] = log1pf(__expf(-lamp[gc]));
    }
    const int xrow = (ht / 40) % 6, cp = ht % 40;
    const int tr = (ht / 20) % 12, cgp = ht % 20;
    f32x4 cw4[4], cb4;
#pragma unroll
    for (int kk = 0; kk < 4; ++kk) cw4[kk] = *(const f32x4*)(convw + kk * 1280 + ch0 + 4 * cgp);
    cb4 = *(const f32x4*)(convb + ch0 + 4 * cgp);
    float hcar = 0.f;
    const int sth = ht - 64 * d;
    int otab[3];
#pragma unroll
    for (int r = 0; r < 3; ++r) { const int e = ht + 256 * r; otab[r] = ((e / 10) << 8) | (2 * (e % 10)); }
    unsigned xr[12];
    const bf16_t* xcol = XG + 1280 + ch0 + 2 * cp;
#define SC_PARAMS(S_, T0_, LS_, RB_, kk_) do { const int s__ = scan_seq(d, (kk_)); S_ = s__; if (s__ < 4) { T0_ = s__ * 64; LS_ = 256; RB_ = ML + b * 256; } else { T0_ = (s__ - 4) * 64; LS_ = 8192; RB_ = b * 8192; } } while (0)
#define SC_PREFETCH(T0_, LS_, RB_) do { _Pragma("unroll") for (int p = 0; p < 12; ++p) { int tt = xrow + 6 * p; tt = tt > 66 ? 66 : tt; int t = (T0_) + tt - 2; t = t < 0 ? 0 : (t >= (LS_) ? (LS_) - 1 : t); \
        xr[p] = *(const unsigned*)(xcol + (size_t)((RB_) + t) * 2560); } } while (0)
#define SC_STAGE(T0_, LS_) do { _Pragma("unroll") for (int p = 0; p < 12; ++p) { int tt = xrow + 6 * p; tt = tt > 66 ? 66 : tt; const int t = (T0_) + tt - 2; const unsigned xv = (t >= 0 && t < (LS_)) ? xr[p] : 0u; \
        *(LAS cf2*)(xraw + tt * 80 + 2 * cp) = MKCF(__builtin_bit_cast(float, xv << 16), __builtin_bit_cast(float, xv & 0xffff0000u)); } } while (0)
#define SC_CONV do { _Pragma("unroll") for (int p = 0; p < 6; ++p) { int tt = tr + 12 * p; tt = tt > 63 ? 63 : tt; f32x4 v = cb4; \
        _Pragma("unroll") for (int kk = 0; kk < 4; ++kk) v += cw4[kk] * *(const LAS f32x4*)(xraw + (tt + kk) * 80 + 4 * cgp); \
        u32x2 w; w.x = pk2(v.x, v.y); w.y = pk2(v.z, v.w); *(LAS u32x2*)(xcb + tt * 96 + 4 * cgp) = w; if (p & 1) __builtin_amdgcn_sched_barrier(0); } } while (0)
    int sA, t0A, LsA, rbA, sB = 0, t0B = 0, LsB = 1, rbB = 0;
    SC_PARAMS(sA, t0A, LsA, rbA, 0); SC_PREFETCH(t0A, LsA, rbA); SC_STAGE(t0A, LsA);
    SC_PARAMS(sB, t0B, LsB, rbB, 1); SC_PREFETCH(t0B, LsB, rbB);
    __syncthreads();
    SC_CONV;
    __syncthreads();
#pragma unroll 1
    for (int k = 0; k < NCH; ++k) {
        if (k + 1 < NCH) SC_STAGE(t0B, LsB);
        int sC = 0, t0C = 0, LsC = 1, rbC = 0;
        if (k + 2 < NCH) { SC_PARAMS(sC, t0C, LsC, rbC, k + 2); SC_PREFETCH(t0C, LsC, rbC); }
        {
            const int mt = hw;
            f32x4 ra[2], ri[2];
#pragma unroll
            for (int nt = 0; nt < 2; ++nt) { ra[nt] = (f32x4){0.f, 0.f, 0.f, 0.f}; ri[nt] = (f32x4){0.f, 0.f, 0.f, 0.f}; }
#pragma unroll
            for (int ks = 0; ks < 3; ++ks) {
                const bf16x8 af = *(const LAS bf16x8*)(xcb + (16 * mt + (lane & 15)) * 96 + 32 * ks + 8 * (lane >> 4));
#pragma unroll
                for (int nt = 0; nt < 2; ++nt) {
                    const bf16x8 wfa = *(const LAS bf16x8*)(Wl + (16 * nt + (lane & 15)) * 96 + 32 * ks + 8 * (lane >> 4));
                    const bf16x8 wfx = *(const LAS bf16x8*)(Wl + 3072 + (16 * nt + (lane & 15)) * 96 + 32 * ks + 8 * (lane >> 4));
                    ra[nt] = MFMA16(af, wfa, ra[nt]); ri[nt] = MFMA16(af, wfx, ri[nt]);
                }
            }
#pragma unroll
            for (int nt = 0; nt < 2; ++nt) {
                {
                    const int dp = 16 * nt + (lane & 15), tb = 16 * mt + 4 * (lane >> 4);
                    f32x4 av4, bv4;
#pragma unroll
                    for (int i = 0; i < 4; ++i) {
                        const float rg = fsigm(ra[nt][i] + bav[nt]), ig = fsigm(ri[nt][i] + bxv[nt]);
                        const float la = -8.0f * rg * spv[nt];
                        const float av = __builtin_amdgcn_exp2f(1.4426950408889634f * la);
                        const float em = fmaxf(1.0f - av * av, 0.f);
                        av4[i] = av;
                        bv4[i] = __builtin_amdgcn_sqrtf(em) * ig * bf2f(xcb[(tb + i) * 96 + q4 * 20 + dp]);
                    }
                    *(LAS f32x4*)(al + dp * 68 + tb) = av4; *(LAS f32x4*)(bl + dp * 68 + tb) = bv4;
                }
            }
        }
        __syncthreads();
        const int kother = (d == 0) ? (sA < 4 ? 3 - sA : 135 - sA) : sA;
        const bool first = k < kother, early = (k - kother) >= 2;
        unsigned pvr[3] = {0u, 0u, 0u}, ggr[3] = {0u, 0u, 0u};
        if (early) {
#pragma unroll
            for (int r = 0; r < 3; ++r) {
                const int e = ht + 256 * r;
                if (e < 640) {
                    const int tt = otab[r] >> 8, dp = otab[r] & 255; const size_t row = (size_t)(rbA + t0A + tt);
                    pvr[r] = __hip_atomic_load((unsigned*)(ACT + row * 1280 + cq0 + dp), __ATOMIC_RELAXED, __HIP_MEMORY_SCOPE_AGENT);
                    ggr[r] = *(const unsigned*)(XG + row * 2560 + cq0 + dp);
                }
            }
        }
        if (sth >= 0 && sth < 20) {
            float hv = hcar;
            if (d == 0) {
#pragma unroll 4
                for (int g = 0; g < 16; ++g) {
                    const f32x4 a4 = *(const LAS f32x4*)(al + sth * 68 + 4 * g), b4 = *(const LAS f32x4*)(bl + sth * 68 + 4 * g); f32x4 o4;
                    hv = a4.x * hv + b4.x; o4.x = hv; hv = a4.y * hv + b4.y; o4.y = hv; hv = a4.z * hv + b4.z; o4.z = hv; hv = a4.w * hv + b4.w; o4.w = hv;
                    *(LAS f32x4*)(hl + sth * 68 + 4 * g) = o4;
                }
            } else {
#pragma unroll 4
                for (int g = 15; g >= 0; --g) {
                    const f32x4 a4 = *(const LAS f32x4*)(al + sth * 68 + 4 * g), b4 = *(const LAS f32x4*)(bl + sth * 68 + 4 * g); f32x4 o4;
                    hv = a4.w * hv + b4.w; o4.w = hv; hv = a4.z * hv + b4.z; o4.z = hv; hv = a4.y * hv + b4.y; o4.y = hv; hv = a4.x * hv + b4.x; o4.x = hv;
                    *(LAS f32x4*)(hl + sth * 68 + 4 * g) = o4;
                }
            }
            hcar = hv;
        }
        if (k + 1 < NCH) SC_CONV;
        asm volatile("s_waitcnt vmcnt(12)" ::: "memory");
        __syncthreads();
        {
#pragma unroll
            for (int r = 0; r < 3; ++r) {
                const int e = ht + 256 * r;
                if (e < 640) {
                    const int tt = otab[r] >> 8, dp = otab[r] & 255; const size_t row = (size_t)(rbA + t0A + tt);
                    const float h0 = hl[dp * 68 + tt], h1 = hl[(dp + 1) * 68 + tt];
                    unsigned* ap = (unsigned*)(ACT + row * 1280 + cq0 + dp);
                    if (first) *ap = pk2(h0, h1);
                    else {
                        const unsigned prev = early ? pvr[r] : __hip_atomic_load(ap, __ATOMIC_RELAXED, __HIP_MEMORY_SCOPE_AGENT);
                        const unsigned gg = early ? ggr[r] : *(const unsigned*)(XG + row * 2560 + cq0 + dp);
                        const float p0 = __builtin_bit_cast(float, prev << 16), p1 = __builtin_bit_cast(float, prev & 0xffff0000u);
                        const float g0 = __builtin_bit_cast(float, gg << 16), g1 = __builtin_bit_cast(float, gg & 0xffff0000u);
                        *ap = pk2((p0 + h0) * fgelu(g0), (p1 + h1) * fgelu(g1));
                    }
                }
            }
        }
        sA = sB; t0A = t0B; LsA = LsB; rbA = rbB; sB = sC; t0B = t0C; LsB = LsC; rbB = rbC;
    }
    __syncthreads();
#undef SC_PARAMS
#undef SC_PREFETCH
#undef SC_STAGE
#undef SC_CONV
}

constexpr int NPHASE = 31;
#ifndef ONLY_KIND
#define ONLY_KIND -1
#endif
#define EN(k) (ONLY_KIND < 0 || ONLY_KIND == (k))
#ifdef PROBE_SUB
#define PROBE_SUBV PROBE_SUB
#else
#define PROBE_SUBV 0
#endif
#ifndef MK_MULTI
#define MK_MULTI 0
#endif
__global__ void __launch_bounds__(NTHR, 2) mega_fwd(KArgs a_by_value) {
    extern __shared__ __attribute__((aligned(16))) unsigned char lds_raw[];
    LAS unsigned char* lds = (LAS unsigned char*)lds_raw;
    cg::grid_group grid = cg::this_grid();
    const int tid0 = threadIdx.x;
    if (tid0 < 2) ((LAS unsigned*)(lds + LDS_BARST))[tid0] = 0u;
    __syncthreads();
    (void)xcd_barrier_post((unsigned*)(a_by_value.ws + WS_BAR), (volatile LAS unsigned*)(lds + LDS_BARST));
    const int G = gridDim.x, bid0 = blockIdx.x, ngw = G * 8;
    const int ph_lo = a_by_value.ph_lo, ph_hi = a_by_value.ph_hi;
#pragma unroll 1
#ifdef PROBE_KIND
    for (int pp = 2 * ph_lo; pp < 2 * ph_hi; ++pp) {
        const int ph = pp >> 1;
#else
    for (int ph = ph_lo; ph < ph_hi; ++ph) {
#endif
        const KArgsP ap = opaque_kargs((KArgsP)__builtin_amdgcn_kernarg_segment_ptr());

        KArgsR a = *ap;
#define KOPQ int tid = tid0; asm volatile("" : "+v"(tid)); const int lane = tid & 63, wid = __builtin_amdgcn_readfirstlane(tid >> 6); int bid = bid0; asm volatile("" : "+s"(bid)); bid = __builtin_amdgcn_readfirstlane(bid); (void)lane; int gw = bid * 8 + wid; asm volatile("" : "+v"(gw)); gw = __builtin_amdgcn_readfirstlane(gw); (void)gw; int i = iL; asm volatile("" : "+s"(i)); i = __builtin_amdgcn_readfirstlane(i); const int j = i >> 1; const bool even = (i & 1) == 0; const int Mrows = (i == 3) ? ML : MT; (void)j; (void)even; (void)Mrows; const KArgsP apb_ = opaque_kargs(ap); KArgsR a = *apb_; unsigned char* ws = a.ws; bf16_t* ACT = (bf16_t*)(ws + WS_ACT); bf16_t* BIG = (bf16_t*)(ws + WS_BIG); bf16_t* WB = (bf16_t*)(ws + WS_WB); bf16_t* HCTX = (bf16_t*)(ws + WS_HCTX); float* MODS = (float*)(ws + WS_MODS); bf16_t* H = (bf16_t*)((unsigned char*)a.out + 64 * MiB); const float* mods_i = MODS + (size_t)i * 5 * 6144; const float* srcLat = (i == 0) ? a.in[0] : nullptr; const float* srcCtx = (i == 0) ? a.in[2] : nullptr; (void)ACT; (void)BIG; (void)WB; (void)HCTX; (void)mods_i; (void)srcLat; (void)srcCtx; (void)H;
        int kind, iL = 0, sub = 0;
        if (ph == 0) kind = 0;
        else if (ph >= NPHASE - 2) { kind = 9; sub = ph - (NPHASE - 2); }
        else {
            const int q = ph - 1, st = q % 7; iL = q / 7;
            const bool ev = (iL & 1) == 0;
            kind = st == 0 ? 1 : st == 1 ? (ev ? 2 : 3) : st == 2 ? (ev ? 4 : 5) : st == 3 ? 7 : st == 4 ? 1 : st == 5 ? 3 : 7;
            sub = (st >= 4) ? 1 : 0;
        }
#ifdef PROBE_KIND
        if ((pp & 1) && kind != PROBE_KIND) continue;
#endif
        if (kind == 0 && EN(0)) { KOPQ
            p0_phase(a, lds, tid, lane, wid);
        } else if (kind == 1 && EN(1)) { KOPQ
            if (sub == 0) {
                norm_rows(srcLat, srcCtx, H, HCTX, a.in[6] + i * 1024, mods_i, 0, 1024, ACT, MT, gw, ngw, lane);
                if (even) { for (int it = bid; it < 512; it += G) khat_item(a, lds, j, it, tid); }
            } else {
                norm_rows(nullptr, nullptr, H, HCTX, a.in[7] + i * 1024, mods_i, 3072, 4096, ACT, Mrows, gw, ngw, lane);
            }
        } else if (kind == 2 && EN(2)) { KOPQ
            pg8::Gemm g{ACT, WB + WB_EVIN + (size_t)j * 3072 * 1024, MT, 3072, 1024}; pg8::StaticOrder S; S.init(MT, 3072, G, bid);
            EpiEvenIn E{(bf16_t*)(ws + WS_BIG + BIG_U), (bf16_t*)(ws + WS_BIG + BIG_Q), (bf16_t*)(ws + WS_BIG + BIG_K), (bf16_t*)(ws + WS_BIG + BIG_VT)};
            pg8::gemm_phase<EpiEvenIn, pg8::StaticOrder, true, true>(lds, g, S, E);
        } else if (kind == 3 && EN(3)) { KOPQ
            const int N = sub ? 4096 : 2560;
            const bf16_t* Bt = sub ? WB + WB_W1 + (size_t)i * 4096 * 1024 : WB + WB_ODIN + (size_t)j * 2560 * 1024;
            const int Mg = sub ? Mrows : MT;
            pg8::Gemm g{ACT, Bt, Mg, N, 1024}; pg8::StaticOrder S; S.init(Mg, N, G, bid);
            EpiStore E{BIG, N, sub};
            pg8::gemm_phase<EpiStore, pg8::StaticOrder, true, true>(lds, g, S, E);
        } else if (kind == 4 && EN(4)) { KOPQ
            const float s1 = wave_sum(a.in[24][j * 64 + lane] * a.in[25][j * 64 + lane], lane), s2 = wave_sum(a.in[26][j * 64 + lane] * a.in[27][j * 64 + lane], lane);
            const float lam_init = 0.8f - 0.6f * __expf(-0.3f * (float)i);
            const float lam = __expf(s1) - __expf(s2) + lam_init;
            const float* subg = a.in[28] + j * 128;
#ifdef PROBE_SUB
            const bool rep_ = (pp & 1);
#else
            const bool rep_ = false;
#endif
            if (!rep_ || PROBE_SUBV == 0)
            {
                const int vcu = (G % 8 == 0) ? (bid % 8) * (G / 8) + bid / 8 : bid;
                for (int it = vcu; it < 528; it += G) {
                    int b, hh, qrow0, ktlo;
                    if (it < 512) { b = it >> 7; hh = (it >> 5) & 3; qrow0 = b * 8192 + (it & 31) * 256; ktlo = 0; }
                    else { const int u = it - 512; b = u >> 2; hh = u & 3; qrow0 = ML + b * 256; ktlo = 128; }
                    attn_unit(a, lds, b, hh, qrow0, ktlo, 132, lam, 1.0f - lam_init, subg, tid);
                }
            }
            if (!rep_ || PROBE_SUBV == 1)
            for (int it = bid; it < 1024; it += G) hyena_lat_item(a, lds, j, it >> 1, it & 1, tid);
            if (!rep_ || PROBE_SUBV == 2)
            for (int it = bid; it < 512; it += G) hyena_ctx_item(a, lds, j, it, tid);
        } else if (kind == 5 && EN(5)) { KOPQ
            for (int cid = bid; cid < 256; cid += G) scan_chain(a, lds, j, cid, tid);
        } else if (kind == 7 && EN(7)) { KOPQ
            const int K = sub ? 4096 : (even ? 1024 : 1280);
            const bf16_t* A = sub ? BIG : ACT;
            const bf16_t* Bt = sub ? WB + WB_W2 + (size_t)i * 4096 * 1024 : (even ? WB + WB_EVOUT + (size_t)j * 1024 * 1024 : WB + WB_ODOUT + (size_t)j * 1024 * 1280);
            pg8::Gemm g{A, Bt, Mrows, 1024, K}; pg8::StaticOrder S; S.init(Mrows, 1024, G, bid);
            EpiResid E{sub ? nullptr : srcLat, sub ? nullptr : srcCtx, H, HCTX, mods_i, sub ? 5120 : 2048};
            pg8::gemm_phase<EpiResid, pg8::StaticOrder, true, true>(lds, g, S, E);
        } else { KOPQ
            if (sub == 0) final_norm(H, a.out, (float*)(ws + WS_ACT), a.in[10], gw, ngw, lane);
            else final_copy((const float*)(ws + WS_ACT), a.out + (size_t)16384 * 1024, bid * NTHR + tid, G * NTHR);
        }
        #ifdef PROBE_SYNCS
        if (ph == 0) { for (int e = 0; e < PROBE_SYNCS; ++e) grid.sync(); }
#endif
#ifdef PROBE_KIND
        if (pp + 1 < 2 * ph_hi) grid.sync();
#else
        if (ph + 1 < ph_hi) { if (ph_hi > 4096) grid.sync(); else { XcdBarrier xb_; xb_.bar = (unsigned*)(ap->ws + WS_BAR); xb_.x = xb_xcc_id(); xb_.st = (volatile LAS unsigned*)(lds + LDS_BARST); xcd_barrier(xb_); } }
#endif
    }
}

extern "C" void kernel_launch(void* const* d_in, const int* in_sizes, int n_in, void* d_out, int out_size, void* d_ws, size_t ws_size, hipStream_t stream) {
    static int grid = 0;
    if (grid == 0) {
        if (n_in != 38 || in_sizes[0] != ML * DM || out_size != ML * DM || ws_size < WS_END) {
            fprintf(stderr, "kernel_launch: unexpected shapes: n_in %d in0 %d out %d ws %zu (need %zu)\n", n_in, n_in > 0 ? in_sizes[0] : -1, out_size, ws_size, (size_t)WS_END); grid = -1; return; }
        int dev = 0, cus = 0, per_cu = 0;
        (void)hipGetDevice(&dev); (void)hipDeviceGetAttribute(&cus, hipDeviceAttributeMultiprocessorCount, dev);
        if (hipFuncSetAttribute((const void*)mega_fwd, hipFuncAttributeMaxDynamicSharedMemorySize, LDS_BYTES) != hipSuccess) { fprintf(stderr, "kernel_launch: hipFuncSetAttribute failed\n"); grid = -1; return; }
        if (hipOccupancyMaxActiveBlocksPerMultiprocessor(&per_cu, (const void*)mega_fwd, NTHR, LDS_BYTES) != hipSuccess || per_cu < 1) { fprintf(stderr, "kernel_launch: occupancy query says %d\n", per_cu); per_cu = 1; }
        (void)hipGetLastError();
        grid = cus * 1;
        if (grid <= 0) grid = 256;
    }
    if (grid < 0) return;
    if (hipMemsetAsync((char*)d_ws + WS_BAR, 0, 16384, stream) != hipSuccess) { fprintf(stderr, "kernel_launch: memset of the barrier words failed\n"); return; }
    KArgs a{};
    for (int k = 0; k < 38; ++k) a.in[k] = (const float*)d_in[k];
    a.out = (float*)d_out; a.ws = (unsigned char*)d_ws;
#if MK_MULTI
    for (int p = 0; p < NPHASE; ++p) { a.ph_lo = p; a.ph_hi = p + 1; hipLaunchKernelGGL(mega_fwd, dim3(grid), dim3(NTHR), LDS_BYTES, stream, a); }
#else
    a.ph_lo = 0; a.ph_hi = NPHASE;
    void* args[] = {&a};
    hipError_t e = hipLaunchCooperativeKernel((const void*)mega_fwd, dim3(grid), dim3(NTHR), args, LDS_BYTES, stream);
    if (e != hipSuccess) fprintf(stderr, "kernel_launch: cooperative launch failed: %s (grid %d)\n", hipGetErrorString(e), grid);
#endif
}
```
